# Optimizing an MI355X kernel written in HIP

```python
import jax, jax.numpy as jnp
from jax import lax
import numpy as np

D_MODEL = 1024
BATCH = 8
SEQ = 4096
DEPTH = 2

CTX_LEN = 256
GRID_W = 64
HEAD_DIM = 64
A_WIDTH = D_MODEL // 2
A_Q_HEADS = A_WIDTH // HEAD_DIM
A_KV_HEADS = A_Q_HEADS // 4
B_WIDTH = D_MODEL // 4
B_GROUPS = 4
B_GROUP_DIM = B_WIDTH // B_GROUPS
C_WIDTH = D_MODEL // 4
C_HEADS = C_WIDTH // HEAD_DIM
MIX_WIDTH = A_WIDTH + B_WIDTH + C_WIDTH
IN_WIDTH = A_WIDTH + 2 * A_KV_HEADS * HEAD_DIM + B_WIDTH + 3 * C_WIDTH
NA_WIN_R = 8
NA_WIN_C = 16
Q_BLOCK = 128
ROPE_THETA = 10000.0
N_EXPERTS = 16
EXPERT_FF = 2 * D_MODEL
CAPACITY_FACTOR = 2
EPS = 1e-6

kernel_name = 'hybrid_fourier_gqa_natten_ec_moe_dit'


def rms_norm(x, g):
    xf = x.astype(jnp.float32)
    y = xf * lax.rsqrt(jnp.mean(xf * xf, axis=-1, keepdims=True) + EPS)
    return (y * g.astype(jnp.float32)).astype(x.dtype)


def modulate(h, shift, scale):
    return h * (1 + scale) + shift


def split_heads(t, n_heads):
    b, n, _ = t.shape
    return t.reshape(b, n, n_heads, HEAD_DIM).transpose(0, 2, 1, 3)


def merge_heads(t):
    b, h, n, d = t.shape
    return t.transpose(0, 2, 1, 3).reshape(b, n, h * d)


def axial_rope_angles(n):
    t = jnp.arange(n, dtype=jnp.int32)
    row = (t // GRID_W).astype(jnp.float32)
    col = (t % GRID_W).astype(jnp.float32)
    n_freq = HEAD_DIM // 4
    inv = ROPE_THETA ** (-jnp.arange(n_freq, dtype=jnp.float32) / n_freq)
    ang = jnp.stack([row[:, None] * inv, col[:, None] * inv], axis=1)
    return jnp.cos(ang), jnp.sin(ang)


def apply_axial_rope(x, cos, sin):
    shp = x.shape
    xr = x.astype(jnp.float32).reshape(shp[:-1] + (2, 2, HEAD_DIM // 4))
    x1, x2 = xr[..., 0, :], xr[..., 1, :]
    out = jnp.stack([x1 * cos - x2 * sin, x1 * sin + x2 * cos], axis=-2)
    return out.reshape(shp).astype(x.dtype)


def gqa_dense(q, k, v):
    b, hq, n, d = q.shape
    hkv = k.shape[1]
    qg = q.reshape(b, hkv, hq // hkv, n, d)
    s = jnp.einsum('bkgnd,bkmd->bkgnm', qg, k, preferred_element_type=jnp.float32) * (d ** -0.5)
    p = jax.nn.softmax(s, axis=-1).astype(v.dtype)
    o = jnp.einsum('bkgnm,bkmd->bkgnd', p, v)
    return o.reshape(b, hq, n, d)


def gqa_blocked(q, k, v):
    b, hq, n, d = q.shape
    nb = n // Q_BLOCK
    qb = q.reshape(b, hq, nb, Q_BLOCK, d).transpose(2, 0, 1, 3, 4)
    out = lax.map(lambda qi: gqa_dense(qi, k, v), qb)
    return out.transpose(1, 2, 0, 3, 4).reshape(b, hq, n, d)


def fourier_mix(u):
    b, n, _ = u.shape
    ug = u.astype(jnp.float32).reshape(b, n, B_GROUPS, B_GROUP_DIM)
    f = jnp.fft.fft2(ug, axes=(1, 3), norm='ortho').real
    return f.reshape(b, n, B_WIDTH).astype(u.dtype)


def neighbourhood_attention(q, k, v, kc, vc, rel_bias):
    b, h, n, d = q.shape
    rows = n // GRID_W
    wr = min(NA_WIN_R, rows)
    wc = min(NA_WIN_C, GRID_W)
    rpb = Q_BLOCK // GRID_W
    nb = rows // rpb
    kg = k.reshape(b, h, rows, GRID_W, d)
    vg = v.reshape(b, h, rows, GRID_W, d)
    cols = jnp.arange(GRID_W)
    cs = jnp.clip(cols - wc // 2, 0, GRID_W - wc)
    col_idx = cs[:, None] + jnp.arange(wc)[None, :]
    col_off = col_idx - cols[:, None] + (NA_WIN_C - 1)
    qb = q.reshape(b, h, nb, rpb, GRID_W, d).transpose(2, 0, 1, 3, 4, 5)
    scale = d ** -0.5
    nwin = wr * wc

    def block(args):
        i, qi = args
        r = i * rpb + jnp.arange(rpb)
        rs = jnp.clip(r - wr // 2, 0, rows - wr)
        row_idx = rs[:, None] + jnp.arange(wr)[None, :]
        row_off = row_idx - r[:, None] + (NA_WIN_R - 1)
        k_win = jnp.take(jnp.take(kg, row_idx, axis=2), col_idx, axis=4)
        v_win = jnp.take(jnp.take(vg, row_idx, axis=2), col_idx, axis=4)
        s_win = jnp.einsum('bhrcd,bhricjd->bhrcij', qi, k_win, preferred_element_type=jnp.float32) * scale
        bias = rel_bias[:, row_off[:, None, :, None], col_off[None, :, None, :]]
        s_win = s_win + bias.astype(jnp.float32)[None]
        s_ctx = jnp.einsum('bhrcd,bhld->bhrcl', qi, kc, preferred_element_type=jnp.float32) * scale
        s = jnp.concatenate([s_win.reshape(b, h, rpb, GRID_W, nwin), s_ctx], axis=-1)
        p = jax.nn.softmax(s, axis=-1).astype(v.dtype)
        p_win = p[..., :nwin].reshape(b, h, rpb, GRID_W, wr, wc)
        p_ctx = p[..., nwin:]
        return (jnp.einsum('bhrcij,bhricjd->bhrcd', p_win, v_win)
                + jnp.einsum('bhrcl,bhld->bhrcd', p_ctx, vc))

    out = lax.map(block, (jnp.arange(nb), qb))
    return out.transpose(1, 2, 0, 3, 4, 5).reshape(b, h, n, d)


def merge_groups(o_a, o_b, o_c, g_out_a, g_out_b, g_out_c, w_out):
    y = jnp.concatenate([rms_norm(o_a, g_out_a), rms_norm(o_b, g_out_b), rms_norm(o_c, g_out_c)], axis=-1)
    return y @ w_out


def mixer_sublayer(hl, hc, w_in, g_q, g_k, rel_bias, g_out_a, g_out_b, g_out_c, w_out, cos, sin, ctx_out):
    kv = A_KV_HEADS * HEAD_DIM
    splits = np.cumsum([A_WIDTH, kv, kv, B_WIDTH, C_WIDTH, C_WIDTH]).tolist()
    qa, ka, va, ub, qn, kn, vn = jnp.split(hl @ w_in, splits, axis=-1)
    qa_c, ka_c, va_c, ub_c, qn_c, kn_c, vn_c = jnp.split(hc @ w_in, splits, axis=-1)
    ka_c = rms_norm(split_heads(ka_c, A_KV_HEADS), g_k)
    va_c = split_heads(va_c, A_KV_HEADS)
    kn_c = split_heads(kn_c, C_HEADS)
    vn_c = split_heads(vn_c, C_HEADS)
    qa = apply_axial_rope(rms_norm(split_heads(qa, A_Q_HEADS), g_q), cos, sin)
    ka = apply_axial_rope(rms_norm(split_heads(ka, A_KV_HEADS), g_k), cos, sin)
    va = split_heads(va, A_KV_HEADS)
    o_a = gqa_blocked(qa, jnp.concatenate([ka, ka_c], axis=2), jnp.concatenate([va, va_c], axis=2))
    o_b = fourier_mix(ub)
    o_c = neighbourhood_attention(split_heads(qn, C_HEADS), split_heads(kn, C_HEADS), split_heads(vn, C_HEADS),
                                  kn_c, vn_c, rel_bias)
    yl = merge_groups(merge_heads(o_a), o_b, merge_heads(o_c), g_out_a, g_out_b, g_out_c, w_out)
    if not ctx_out:
        return yl, None
    o_a_c = gqa_dense(rms_norm(split_heads(qa_c, A_Q_HEADS), g_q), ka_c, va_c)
    o_b_c = fourier_mix(ub_c)
    o_c_c = gqa_dense(split_heads(qn_c, C_HEADS), kn_c, vn_c)
    yc = merge_groups(merge_heads(o_a_c), o_b_c, merge_heads(o_c_c), g_out_a, g_out_b, g_out_c, w_out)
    return yl, yc


def expert_choice_moe(h, w_router, w_gate, w_up, w_down):
    b, n, d = h.shape
    cap = max(1, CAPACITY_FACTOR * n // N_EXPERTS)
    logits = jnp.einsum('bnd,de->ben', h, w_router, preferred_element_type=jnp.float32)
    aff = jax.nn.softmax(logits, axis=1)
    gate, idx = lax.top_k(aff, cap)
    xe = jax.vmap(lambda hb, ib: hb[ib])(h, idx)
    g = jnp.einsum('becd,edf->becf', xe, w_gate)
    u = jnp.einsum('becd,edf->becf', xe, w_up)
    y = jnp.einsum('becf,efd->becd', jax.nn.silu(g) * u, w_down) * gate[..., None].astype(h.dtype)

    def scatter(ib, yb):
        return jnp.zeros((n, d), h.dtype).at[ib.reshape(-1)].add(yb.reshape(-1, d))

    return jax.vmap(scatter)(idx, y)


def setup_inputs(seed: int = 0) -> dict:
    key = jax.random.key(seed)
    ks = jax.random.split(key, 24)
    D = D_MODEL
    nrm = jax.random.normal

    def gain(k, shape):
        return 1.0 + 0.02 * nrm(k, shape, jnp.float32)

    return {
        'x': nrm(ks[0], (BATCH, SEQ, D), jnp.float32),
        'c': nrm(ks[1], (BATCH, D), jnp.float32),
        'ctx': nrm(ks[2], (BATCH, CTX_LEN, D), jnp.float32),
        'c_ctx': nrm(ks[3], (D,), jnp.float32),
        'w_ada': nrm(ks[4], (DEPTH, D, 6 * D), jnp.float32) * D ** -0.5,
        'b_ada': 0.01 * nrm(ks[5], (DEPTH, 6 * D), jnp.float32),
        'g_mix': gain(ks[6], (DEPTH, D)),
        'g_ffn': gain(ks[7], (DEPTH, D)),
        'w_in': nrm(ks[8], (DEPTH, D, IN_WIDTH), jnp.float32) * D ** -0.5,
        'g_q': gain(ks[9], (DEPTH, HEAD_DIM)),
        'g_k': gain(ks[10], (DEPTH, HEAD_DIM)),
        'rel_bias': 0.1 * nrm(ks[11], (DEPTH, C_HEADS, 2 * NA_WIN_R - 1, 2 * NA_WIN_C - 1), jnp.float32),
        'g_out_a': gain(ks[12], (DEPTH, A_WIDTH)),
        'g_out_b': gain(ks[13], (DEPTH, B_WIDTH)),
        'g_out_c': gain(ks[14], (DEPTH, C_WIDTH)),
        'w_out': nrm(ks[15], (DEPTH, MIX_WIDTH, D), jnp.float32) * MIX_WIDTH ** -0.5,
        'w_router': nrm(ks[16], (DEPTH, D, N_EXPERTS), jnp.float32) * D ** -0.5,
        'w_gate': nrm(ks[17], (DEPTH, N_EXPERTS, D, EXPERT_FF), jnp.float32) * D ** -0.5,
        'w_up': nrm(ks[18], (DEPTH, N_EXPERTS, D, EXPERT_FF), jnp.float32) * D ** -0.5,
        'w_down': nrm(ks[19], (DEPTH, N_EXPERTS, EXPERT_FF, D), jnp.float32) * EXPERT_FF ** -0.5,
        'g_final': gain(ks[20], (D,)),
    }


def reference(x, c, ctx, c_ctx, w_ada, b_ada, g_mix, g_ffn, w_in, g_q, g_k, rel_bias, g_out_a, g_out_b,
              g_out_c, w_out, w_router, w_gate, w_up, w_down, g_final):
    n = x.shape[1]
    cos, sin = axial_rope_angles(n)
    sc = jax.nn.silu(c)
    sx = jax.nn.silu(c_ctx)
    xl, xc = x, ctx
    for l in range(DEPTH):
        last = l == DEPTH - 1
        ml = [m[:, None, :] for m in jnp.split(sc @ w_ada[l] + b_ada[l], 6, axis=-1)]
        mc = jnp.split(sx @ w_ada[l] + b_ada[l], 6, axis=-1)
        hl = modulate(rms_norm(xl, g_mix[l]), ml[0], ml[1])
        hc = modulate(rms_norm(xc, g_mix[l]), mc[0], mc[1])
        yl, yc = mixer_sublayer(hl, hc, w_in[l], g_q[l], g_k[l], rel_bias[l], g_out_a[l], g_out_b[l],
                                g_out_c[l], w_out[l], cos, sin, not last)
        xl = xl + ml[2] * yl
        hl = modulate(rms_norm(xl, g_ffn[l]), ml[3], ml[4])
        xl = xl + ml[5] * expert_choice_moe(hl, w_router[l], w_gate[l], w_up[l], w_down[l])
        if not last:
            xc = xc + mc[2] * yc
            hc = modulate(rms_norm(xc, g_ffn[l]), mc[3], mc[4])
            xc = xc + mc[5] * expert_choice_moe(hc, w_router[l], w_gate[l], w_up[l], w_down[l])
    return rms_norm(xl, g_final)
```

```cpp
#include <hip/hip_runtime.h>
#include <hip/hip_bf16.h>
#include <cstdio>
#include <cstdint>

#ifndef MK_PER_PHASE
#define MK_PER_PHASE 0
#endif
#ifndef DBG_STOP
#define DBG_STOP 99
#endif
#ifndef DBG_GROUPS
#define DBG_GROUPS 7
#endif

#ifndef F8MODE
#define F8MODE 2
#endif
#ifndef INPROJ_F8
#define INPROJ_F8 0
#endif
#ifndef ATT_F8
#define ATT_F8 1
#endif
#ifndef PV_F8
#define PV_F8 1
#endif
#ifndef DMA_ROLES
#define DMA_ROLES 1
#endif
#ifndef YS_F8
#define YS_F8 1
#endif
#ifndef G_SADDR
#define G_SADDR 1
#endif
#ifndef G_FRESH
#define G_FRESH 1
#endif
#ifndef G_RO1
#define G_RO1 1
#endif
#ifndef G_UNI
#define G_UNI 0
#endif
#ifndef G_NORON
#define G_NORON 1
#endif
#ifndef G_SBASE
#define G_SBASE 1
#endif
#ifndef PROBE_DUP
#define PROBE_DUP 0
#endif
#define REPS(k) ((PROBE_DUP == (k)) ? 2 : 1)
#define GAS __attribute__((address_space(1)))
#define LAS __attribute__((address_space(3)))
typedef unsigned short bf16_t;
typedef short bf16x8 __attribute__((ext_vector_type(8)));
typedef short s16x4 __attribute__((ext_vector_type(4)));
typedef float f32x2 __attribute__((ext_vector_type(2)));
typedef float f32x4 __attribute__((ext_vector_type(4)));
typedef float f32x16 __attribute__((ext_vector_type(16)));
typedef unsigned u32x2 __attribute__((ext_vector_type(2)));
typedef unsigned u32x4 __attribute__((ext_vector_type(4)));
typedef int i32x4v __attribute__((ext_vector_type(4)));
typedef int i32x8v __attribute__((ext_vector_type(8)));
typedef int i32x2v __attribute__((ext_vector_type(2)));
typedef long i64x2v __attribute__((ext_vector_type(2)));

constexpr int NB = 8, SEQ = 4096, CTX = 256, TT = SEQ + CTX  , MROWS = NB * TT  , DM = 1024;
constexpr int NQ = 2048;
constexpr int C_QA = 0, C_KA = 512, C_VA = 640, C_VR = 768, C_VI = 1024, C_QN = 1280, C_KN = 1536, C_VN = 1792;
constexpr size_t MR_ = (size_t)8 * 4352;
constexpr size_t O_QA = 0, O_KA = MR_ * 512, O_VA = O_KA + MR_ * 128, O_VRI = O_VA + MR_ * 128, O_QN = O_VRI + MR_ * 512, O_KN = O_QN + MR_ * 256, O_VN = O_KN + MR_ * 256;
constexpr int NE = 16, FF = 2048, CAP = 512, CAPC = 32;
constexpr int ERT = 17;
constexpr int EROWS = ERT * 256;
constexpr float EPS = 1e-6f;
constexpr float LOG2E = 1.4426950408889634f;
constexpr float WSC8 = 64.0f;
constexpr float C2 = 0.125f * LOG2E;

constexpr size_t MiB = 1u << 20;
constexpr size_t WS_CTL = 0, CTL_ZERO_BYTES = 1 * MiB;
constexpr size_t WS_MODP = 1 * MiB;
constexpr size_t WS_MOD = 5 * MiB;
constexpr size_t WS_TAB = 6 * MiB;
constexpr size_t TAB_ROPE = 0, TAB_M1 = 8192, TAB_W3 = 8192 + 32768, TAB_TW = 8192 + 32768 + 16384, TAB_TWC = TAB_TW + 32768, TAB_CSC = 131072  ;
constexpr size_t WS_AFF = 7 * MiB;
constexpr size_t WS_SEL = 10 * MiB;
constexpr size_t WS_IDX = 13 * MiB;
constexpr size_t WS_WIN = 16 * MiB;
constexpr size_t WS_WOUT = 24 * MiB;
constexpr size_t WS_WGU = 28 * MiB;
constexpr size_t WS_WD = 284 * MiB;
constexpr size_t WS_X = 412 * MiB;
constexpr size_t WS_R = 548 * MiB;
constexpr size_t WS_QKV = WS_R, WS_OCAT = WS_R + 136 * MiB, WS_H = WS_R + 204 * MiB, WS_ACT = WS_R;
constexpr size_t WS_YS = 820 * MiB;
constexpr size_t WS_H2 = WS_YS;
constexpr size_t WS_XE = WS_YS;
constexpr size_t WS_ST = 960 * MiB;
constexpr size_t WS_END = 972 * MiB;

constexpr int CW_TMO = 0, CW_Q0 = 64  , CW_BAR = 4096;

constexpr int RING_BYTES = 149504;
constexpr int RS_OFF = 131072;
constexpr int GI_OFF = 131072;
constexpr int LDSCTL_OFF = RING_BYTES, MISC_OFF = LDSCTL_OFF + 320;
constexpr int LDS_BYTES = 151552;

#define LDS_WAIT() asm volatile("s_waitcnt lgkmcnt(0)" ::: "memory")
#define VM_WAIT() asm volatile("s_waitcnt vmcnt(0)" ::: "memory")
__device__ __forceinline__ unsigned f2bf(float f) { unsigned u = __builtin_bit_cast(unsigned, f); return (u + 0x7fffu + ((u >> 16) & 1u)) >> 16; }
typedef __bf16 hwbf16x2_t __attribute__((ext_vector_type(2)));
__device__ __forceinline__ unsigned pk2(float lo, float hi) { f32x2 v = {lo, hi}; hwbf16x2_t b = __builtin_convertvector(v, hwbf16x2_t); return __builtin_bit_cast(unsigned, b); }
__device__ __forceinline__ unsigned pk4_fp8(float a, float b, float c, float d) { int w; asm volatile("" : "=v"(w));
    w = __builtin_amdgcn_cvt_pk_fp8_f32(a, b, w, false); w = __builtin_amdgcn_cvt_pk_fp8_f32(c, d, w, true); return (unsigned)w; }
__device__ __forceinline__ float bf2f(unsigned short h) { return __builtin_bit_cast(float, (unsigned)h << 16); }
__device__ __forceinline__ float bflo(unsigned w) { return __builtin_bit_cast(float, w << 16); }
__device__ __forceinline__ float bfhi(unsigned w) { return __builtin_bit_cast(float, w & 0xffff0000u); }
__device__ __forceinline__ int tid_fresh() { int t = threadIdx.x; asm volatile("" : "+v"(t)); return t; }
__device__ __forceinline__ float shx(float v, int mask, int lane) { return __builtin_bit_cast(float, __builtin_amdgcn_ds_bpermute((lane ^ mask) << 2, __builtin_bit_cast(int, v))); }
__device__ __forceinline__ unsigned shidx(unsigned v, int src_lane) { return (unsigned)__builtin_amdgcn_ds_bpermute(src_lane << 2, (int)v); }
__device__ __forceinline__ float wave_sum(float v, int lane) {
#pragma unroll
    for (int o = 1; o < 64; o <<= 1) v += shx(v, o, lane);
    return v;
}

namespace pg8 {
constexpr int BM = 256, BK = 64, HALF = 128, HTB = HALF * BK * 2, NXCD = 8;
__host__ __device__ __forceinline__ int lds_byte(int r, int c) { const int st = (r >> 4) * 2 + (c >> 5), rr = r & 15, cc = c & 31, ob = rr * 64 + cc * 2; return st * 1024 + (ob ^ (((ob >> 9) & 1) << 5)); }
__host__ __device__ __forceinline__ void stage_rc(int b, int& R, int& C) { const int st = b / 1024, sb = b % 1024, swz = sb ^ (((sb >> 9) & 1) << 5); R = (st >> 1) * 16 + swz / 64; C = (st & 1) * 32 + (swz % 64) / 2; }
__host__ __device__ __forceinline__ int perm32(int rho) { const int n = rho >> 4, i = rho & 15; return 8 * (i >> 2) + 4 * n + (i & 3); }

struct Unit { int pm, pn, pb; };
struct Gemm { const bf16_t* A; const bf16_t* Bt; int K; };

__device__ __forceinline__ unsigned cvt_pk_bf16(float lo, float hi) { unsigned r; asm volatile("v_cvt_pk_bf16_f32 %0, %1, %2" : "=v"(r) : "v"(lo), "v"(hi)); return r; }

template <class Epi, class Sched, bool ALIGN_EPI = false, bool GATHER = false, bool KSCALE = false, bool F8 = false>
__device__ __forceinline__ void gemm_phase(LAS unsigned char* lds, const Gemm g, const Sched& S, Epi E, const int* gidx = nullptr) {
    const int tid = tid_fresh(), wid = __builtin_amdgcn_readfirstlane(tid >> 6), lane = tid & 63, wr = wid >> 2, wc = wid & 3, fr = lane & 15, fq = lane >> 4;
    const int K = g.K, nt = K / BK;
    unsigned voffB;
    { int R, C; stage_rc(tid * 16, R, C); const int Rb = ((R & ~31) + perm32(R & 31)); voffB = (unsigned)(Rb * K + C) * 2u; }
    const unsigned rowb = (unsigned)K * 2u;
    unsigned voffA = 0; if constexpr (!GATHER && G_SBASE) { int R, C; stage_rc(tid * 16, R, C); voffA = (unsigned)R * rowb + (unsigned)C * 2u; }
#define PG8_ROWOFF(dst, pm_, uo_) do { if constexpr (!GATHER && G_SBASE) { _Pragma("unroll") for (int h_ = 0; h_ < 2; ++h_) { dst[h_][0] = (unsigned)((pm_) * BM + h_ * HALF) * rowb; dst[h_][1] = 0u; } } else { \
        const int tq_ = G_FRESH ? tid_fresh() : tid; _Pragma("unroll") for (int i_ = 0; i_ < 2; ++i_) { int R_, C_; stage_rc(tq_ * 16 + i_ * 8192, R_, C_); \
        _Pragma("unroll") for (int h_ = 0; h_ < 2; ++h_) { const int r_ = (pm_) * BM + h_ * HALF + R_; dst[h_][i_] = (unsigned)(GATHER ? ((const LAS int*)(lds + GI_OFF))[(uo_) * 256 + h_ * HALF + R_] : r_) * rowb + (unsigned)C_ * 2u; } } } } while (0)
    const size_t kstep = (size_t)(BK * 2);
    const size_t hstep = (size_t)HALF * K * 2;
    const size_t tstep = 2 * hstep;
    const unsigned ldsw = (unsigned)wid * 1024u;
    const int aoff = lds_byte(wr * 64 + fr, fq * 8), boff = lds_byte(wc * 32 + fr, fq * 8);
#define PG8_SA(b, h) (((b) * 2 + (h)) * HTB)
#define PG8_SB(b, h) ((4 + (b) * 2 + (h)) * HTB)
#if G_SADDR
#define PG8_OPQ(x) ({ unsigned o_ = (x); asm volatile("" : "+v"(o_)); o_; })
#if G_UNI
#define PG8_UNI(p) ({ const char* p_ = (p); asm volatile("" : "+s"(p_)); p_; })
#else
#define PG8_UNI(p) (p)
#endif
#else
#define PG8_OPQ(x) (x)
#define PG8_UNI(p) (p)
#endif
#define PG8_STAGE(bufoff, gbase, voff) do { _Pragma("unroll") for (int _i = 0; _i < 2; ++_i) \
        __builtin_amdgcn_global_load_lds((const unsigned*)(PG8_UNI((const char*)(gbase) + (size_t)_i * 64 * rowb) + PG8_OPQ(voff)), (LAS unsigned*)(lds + (bufoff) + ldsw + _i * 8192), 16, 0, 0); } while (0)
#define PG8_STAGE_A(bufoff, ro, h, koff) do { _Pragma("unroll") for (int _i = 0; _i < 2; ++_i) \
        __builtin_amdgcn_global_load_lds((const unsigned*)(PG8_UNI((const char*)g.A + (size_t)(koff) + (GATHER ? (size_t)0 : (size_t)_i * 64 * rowb + (G_SBASE ? (size_t)(ro)[h][0] : (size_t)0))) + PG8_OPQ(GATHER ? (ro)[h][_i] : (G_SBASE ? voffA : (ro)[h][0]))), (LAS unsigned*)(lds + (bufoff) + ldsw + _i * 8192), 16, 0, 0); } while (0)
#define PG8_LDA(dst, b, h) do { _Pragma("unroll") for (int m = 0; m < 4; ++m) _Pragma("unroll") for (int k = 0; k < 2; ++k) dst[m][k] = *(const LAS bf16x8*)(lds + PG8_SA(b, h) + aoff + m * 2048 + k * 1024); } while (0)
#define PG8_LDB(dst, b, h) do { _Pragma("unroll") for (int n = 0; n < 2; ++n) _Pragma("unroll") for (int k = 0; k < 2; ++k) dst[n][k] = *(const LAS bf16x8*)(lds + PG8_SB(b, h) + boff + n * 2048 + k * 1024); } while (0)
#define PG8_CAT(x0, x1) __builtin_shufflevector(__builtin_bit_cast(i32x4v, x0), __builtin_bit_cast(i32x4v, x1), 0, 1, 2, 3, 4, 5, 6, 7)
#define PG8_MMA(ai, bj, At, Bt) do { __builtin_amdgcn_s_setprio(1); _Pragma("unroll") for (int m = 0; m < 4; ++m) _Pragma("unroll") for (int n = 0; n < 2; ++n) { \
        if constexpr (F8 && F8MODE == 2) { const i32x8v b8_ = PG8_CAT(Bt[n][0], Bt[n][1]), a8_ = PG8_CAT(At[m][0], At[m][1]); acc[ai][bj][m][n] = __builtin_amdgcn_mfma_scale_f32_16x16x128_f8f6f4(b8_, a8_, acc[ai][bj][m][n], 0, 0, 0, 0, 0, 0); } \
        else if constexpr (F8) { _Pragma("unroll") for (int k = 0; k < 2; ++k) { const i64x2v b2_ = __builtin_bit_cast(i64x2v, Bt[n][k]), a2_ = __builtin_bit_cast(i64x2v, At[m][k]); \
            acc[ai][bj][m][n] = __builtin_amdgcn_mfma_f32_16x16x32_fp8_fp8(b2_[0], a2_[0], acc[ai][bj][m][n], 0, 0, 0); acc[ai][bj][m][n] = __builtin_amdgcn_mfma_f32_16x16x32_fp8_fp8(b2_[1], a2_[1], acc[ai][bj][m][n], 0, 0, 0); } } \
        else { _Pragma("unroll") for (int k = 0; k < 2; ++k) acc[ai][bj][m][n] = __builtin_amdgcn_mfma_f32_16x16x32_bf16(Bt[n][k], At[m][k], acc[ai][bj][m][n], 0, 0, 0); } } __builtin_amdgcn_s_setprio(0); } while (0)
#define PG8_WAIT_V(n) asm volatile("s_waitcnt vmcnt(" #n ")" ::: "memory")
#define PG8_WAIT_L(n) asm volatile("s_waitcnt lgkmcnt(" #n ")" ::: "memory")
#define PG8_BAR __builtin_amdgcn_s_barrier()
#define PG8_SCHED __builtin_amdgcn_sched_barrier(0)
    Unit cur, nxt; int ui = 0;
    if (!S.next(0, cur)) return;
    f32x4 acc[2][2][4][2];
#pragma unroll
    for (int a = 0; a < 2; ++a)
#pragma unroll
        for (int b = 0; b < 2; ++b)
#pragma unroll
            for (int m = 0; m < 4; ++m)
#pragma unroll
                for (int n = 0; n < 2; ++n) acc[a][b][m][n] = (f32x4){0.f, 0.f, 0.f, 0.f};
    bf16x8 At[4][2], B0[2][2], B1[2][2];
    unsigned roC[2][2], roN[2][2];
    if constexpr (GATHER) {
        Unit u_; for (int i_ = 0; i_ < 17 && S.next(i_, u_); ++i_) { if (tid < 256) ((LAS int*)(lds + GI_OFF))[i_ * 256 + tid] = gidx[u_.pm * BM + tid]; }
        __syncthreads(); }
    PG8_ROWOFF(roC, cur.pm, 0);
    const char* cB = (const char*)g.Bt + (size_t)cur.pb * tstep;
    {
        PG8_STAGE(PG8_SB(0, 0), cB, voffB); PG8_STAGE(PG8_SB(0, 1), cB + hstep, voffB); PG8_STAGE_A(PG8_SA(0, 0), roC, 0, 0); PG8_STAGE_A(PG8_SA(0, 1), roC, 1, 0);
        if (wr == 1) PG8_BAR;
        PG8_WAIT_V(2); PG8_BAR;
        PG8_STAGE(PG8_SB(1, 0), cB + kstep, voffB); PG8_STAGE_A(PG8_SA(1, 0), roC, 0, kstep); PG8_STAGE(PG8_SB(1, 1), cB + hstep + kstep, voffB);
        PG8_WAIT_V(6); PG8_BAR;
    }
    for (;;) {
        const bool has_next = S.next(ui + 1, nxt);
        const char* nB = has_next ? (const char*)g.Bt + (size_t)nxt.pb * tstep : cB;
        if constexpr (GATHER) {
            if (G_NORON) {}
            else if (has_next) PG8_ROWOFF(roN, nxt.pm, ui + 1);
            else {
#pragma unroll
                for (int h_ = 0; h_ < 2; ++h_)
#pragma unroll
                    for (int i_ = 0; i_ < 2; ++i_) roN[h_][i_] = roC[h_][i_]; } }
        for (int seg = 0; seg < (KSCALE ? 3 : 1); ++seg) {
        const int tb = KSCALE ? (seg == 0 ? 0 : (seg == 1 ? 8 : 12)) : 0, te = KSCALE ? (seg == 0 ? 8 : (seg == 1 ? 12 : nt)) : nt;
        if constexpr (KSCALE) { if (seg > 0) { const LAS float* rs = (const LAS float*)(lds + RS_OFF) + ui * 768 + (seg - 1);
#pragma unroll
                for (int a = 0; a < 2; ++a)
#pragma unroll
                    for (int m = 0; m < 4; ++m) { const float f = rs[(a * HALF + wr * 64 + m * 16 + fr) * 3];
#pragma unroll
                        for (int b = 0; b < 2; ++b)
#pragma unroll
                            for (int n = 0; n < 2; ++n) acc[a][b][m][n] = acc[a][b][m][n] * f; } } }
        for (int t = tb; t < te; t += 2) {
            const bool last = (t == nt - 2);
            const size_t k1 = (size_t)(t + 1) * kstep;
            const size_t k2 = last ? (size_t)0 : (size_t)(t + 2) * kstep, k3 = k2 + kstep;
            const char* b2 = last ? nB : cB + (size_t)(t + 2) * kstep; const char* b3 = b2 + kstep;
            constexpr bool RO1 = GATHER && G_NORON && G_RO1;
            unsigned ro2[2][2];
            if constexpr (!RO1) {
#pragma unroll
            for (int h_ = 0; h_ < 2; ++h_)
#pragma unroll
                for (int i_ = 0; i_ < 2; ++i_) ro2[h_][i_] = roC[h_][i_]; }
            auto& roU = *(RO1 ? &roC : &ro2);
            if (!RO1 && last) {
                if constexpr (!GATHER) { const int pmn = has_next ? nxt.pm : cur.pm; PG8_ROWOFF(ro2, pmn, 0);
                    if constexpr (G_SBASE) { asm volatile("" : "+s"(ro2[0][0]), "+s"(ro2[1][0])); }
                    else {
#pragma unroll
                    for (int h_ = 0; h_ < 2; ++h_)
#pragma unroll
                        for (int i_ = 0; i_ < 2; ++i_) asm volatile("" : "+v"(ro2[h_][i_])); } }
                else if constexpr (G_NORON) { const int uo2 = has_next ? ui + 1 : ui; PG8_ROWOFF(ro2, 0, uo2);
#pragma unroll
                    for (int h_ = 0; h_ < 2; ++h_)
#pragma unroll
                        for (int i_ = 0; i_ < 2; ++i_) asm volatile("" : "+v"(ro2[h_][i_])); }
                else {
#pragma unroll
                    for (int h_ = 0; h_ < 2; ++h_)
#pragma unroll
                        for (int i_ = 0; i_ < 2; ++i_) { asm volatile("" : "+v"(roN[h_][i_])); ro2[h_][i_] = roN[h_][i_]; } } }
            PG8_LDB(B0, 0, 0); PG8_LDB(B1, 0, 1); PG8_SCHED; PG8_LDA(At, 0, 0); PG8_STAGE_A(PG8_SA(1, 1), roC, 1, k1);
            if constexpr (RO1) { if (last) { const int uo2 = has_next ? ui + 1 : ui; PG8_ROWOFF(roC, 0, uo2);
#pragma unroll
                    for (int h_ = 0; h_ < 2; ++h_)
#pragma unroll
                        for (int i_ = 0; i_ < 2; ++i_) asm volatile("" : "+v"(roC[h_][i_])); } }
            PG8_WAIT_V(8); PG8_WAIT_L(0); PG8_BAR; PG8_MMA(0, 0, At, B0); PG8_MMA(0, 1, At, B1); PG8_BAR; PG8_SCHED;
            PG8_LDA(At, 0, 1); PG8_STAGE(PG8_SB(0, 0), b2, voffB); PG8_STAGE(PG8_SB(0, 1), b2 + hstep, voffB); PG8_STAGE_A(PG8_SA(0, 0), roU, 0, k2);
            PG8_WAIT_V(8); PG8_WAIT_L(0); PG8_BAR; PG8_MMA(1, 0, At, B0); PG8_MMA(1, 1, At, B1); PG8_BAR; PG8_SCHED;
            PG8_LDB(B0, 1, 0); PG8_LDB(B1, 1, 1); PG8_SCHED; PG8_LDA(At, 1, 0); PG8_STAGE_A(PG8_SA(0, 1), roU, 1, k2);
            PG8_WAIT_V(8); PG8_WAIT_L(0); PG8_BAR; PG8_MMA(0, 0, At, B0); PG8_MMA(0, 1, At, B1); PG8_BAR; PG8_SCHED;
            PG8_LDA(At, 1, 1); PG8_STAGE(PG8_SB(1, 0), b3, voffB); PG8_STAGE(PG8_SB(1, 1), b3 + hstep, voffB); PG8_STAGE_A(PG8_SA(1, 0), roU, 0, k3);
            PG8_WAIT_V(8); PG8_WAIT_L(0); PG8_BAR; PG8_MMA(1, 0, At, B0); PG8_MMA(1, 1, At, B1); PG8_BAR; PG8_SCHED;
        }
        }
        if constexpr (ALIGN_EPI) { if (wr == 0) PG8_BAR; }
        if constexpr (KSCALE) E.rs3 = (const LAS float*)(lds + RS_OFF) + ui * 768 + 2;
        if constexpr (G_FRESH) { const int te_ = tid_fresh(), le_ = te_ & 63, we_ = __builtin_amdgcn_readfirstlane(te_ >> 6); E(acc, cur, we_ >> 2, we_ & 3, le_ & 15, le_ >> 4); }
        else E(acc, cur, wr, wc, fr, fq);
        if (!has_next) break;
#pragma unroll
        for (int a = 0; a < 2; ++a)
#pragma unroll
            for (int b = 0; b < 2; ++b)
#pragma unroll
                for (int m = 0; m < 4; ++m)
#pragma unroll
                    for (int n = 0; n < 2; ++n) acc[a][b][m][n] = (f32x4){0.f, 0.f, 0.f, 0.f};
        cur = nxt; cB = nB; ++ui;
        if constexpr (GATHER && !G_NORON) {
#pragma unroll
            for (int h_ = 0; h_ < 2; ++h_)
#pragma unroll
                for (int i_ = 0; i_ < 2; ++i_) roC[h_][i_] = roN[h_][i_]; }
        else PG8_ROWOFF(roC, cur.pm, ui);
        if constexpr (ALIGN_EPI) { if (wr == 1) PG8_BAR; }
    }
    PG8_WAIT_V(0);
    if constexpr (!ALIGN_EPI) { if (wr == 0) PG8_BAR; }
    PG8_BAR;
#undef PG8_SA
#undef PG8_SB
#undef PG8_STAGE
#undef PG8_STAGE_A
#undef PG8_ROWOFF
#undef PG8_LDA
#undef PG8_LDB
#undef PG8_MMA
#undef PG8_OPQ
#undef PG8_UNI
#undef PG8_CAT
#undef PG8_WAIT_V
#undef PG8_WAIT_L
#undef PG8_BAR
#undef PG8_SCHED
}

struct GridOrder {
    int nM, nN, nwg, G, c, skipctx;
    __device__ __forceinline__ void init(int nM_, int nN_, int G_, int c_, int skipctx_) { nM = nM_; nN = nN_; nwg = nM * nN; G = G_; c = c_; skipctx = skipctx_; }
    __device__ __forceinline__ bool next(int i, Unit& u) const {
        const long L = (long)i * G + c; if (L >= nwg) return false;
        int wgid = (int)L; { const int q = nwg / NXCD, r = nwg % NXCD, xcd = wgid % NXCD, off = wgid / NXCD; wgid = (xcd < r ? xcd * (q + 1) : r * (q + 1) + (xcd - r) * q) + off; }
        const int WGM = 8; const int nig = WGM * nN, gid = wgid / nig, fm = gid * WGM, gsz = (nM - fm) < WGM ? (nM - fm) : WGM;
        int pm = fm + ((wgid % nig) % gsz); u.pn = (wgid % nig) / gsz; u.pb = u.pn;
        if (skipctx) pm = (pm >> 4) * 17 + (pm & 15);
        u.pm = pm; return true;
    }
};
struct MoeOrder {
    int rt, ct, x, ci, upe;
    __device__ __forceinline__ void init(int rt_, int ct_, int c_) { rt = rt_; ct = ct_; x = c_ & 7; ci = c_ >> 3; upe = rt * ct; }
    __device__ __forceinline__ bool next(int i, Unit& u) const {
        const int j = i * 32 + ci; if (j >= 2 * upe) return false;
        const int e = 2 * x + j / upe, w = j % upe;
        const int nig = 4 * ct, gid = w / nig, fm = gid * 4, gsz = (rt - fm) < 4 ? (rt - fm) : 4;
        const int pml = fm + ((w % nig) % gsz), pnl = (w % nig) / gsz;
        u.pm = e * ERT + pml; u.pn = pnl; u.pb = e * ct + pnl; return true;
    }
};

struct EpiStore {
    bf16_t* O; int ldc;
    __device__ __forceinline__ void operator()(const f32x4 (&acc)[2][2][4][2], const Unit& u, int wr, int wc, int fr, int fq) const {
        const int row0 = u.pm * BM + wr * 64 + fr, col0 = u.pn * BM + wc * 32 + 8 * fq;
#pragma unroll
        for (int ai = 0; ai < 2; ++ai)
#pragma unroll
            for (int m = 0; m < 4; ++m) { bf16_t* rowp = O + (size_t)(row0 + ai * HALF + m * 16) * ldc + col0;
#pragma unroll
                for (int bj = 0; bj < 2; ++bj) { const f32x4 v0 = acc[ai][bj][m][0], v1 = acc[ai][bj][m][1];
                    u32x4 w; w.x = cvt_pk_bf16(v0[0], v0[1]); w.y = cvt_pk_bf16(v0[2], v0[3]); w.z = cvt_pk_bf16(v1[0], v1[1]); w.w = cvt_pk_bf16(v1[2], v1[3]);
                    *(u32x4*)(rowp + bj * HALF) = w; } }
    }
};
struct EpiStoreS {
    bf16_t* O; int ldc; float sc;
    __device__ __forceinline__ void operator()(const f32x4 (&acc)[2][2][4][2], const Unit& u, int wr, int wc, int fr, int fq) const {
        const int row0 = u.pm * BM + wr * 64 + fr, col0 = u.pn * BM + wc * 32 + 8 * fq;
#pragma unroll
        for (int ai = 0; ai < 2; ++ai)
#pragma unroll
            for (int m = 0; m < 4; ++m) { bf16_t* rowp = O + (size_t)(row0 + ai * HALF + m * 16) * ldc + col0;
#pragma unroll
                for (int bj = 0; bj < 2; ++bj) { const f32x4 v0 = acc[ai][bj][m][0] * sc, v1 = acc[ai][bj][m][1] * sc;
#if YS_F8
                    u32x2 w8; w8.x = pk4_fp8(v0[0], v0[1], v0[2], v0[3]); w8.y = pk4_fp8(v1[0], v1[1], v1[2], v1[3]);
                    *(u32x2*)((unsigned char*)O + ((size_t)(row0 + ai * HALF + m * 16) * ldc + col0 + bj * HALF)) = w8; (void)rowp;
#else
                    u32x4 w; w.x = cvt_pk_bf16(v0[0], v0[1]); w.y = cvt_pk_bf16(v0[2], v0[3]); w.z = cvt_pk_bf16(v1[0], v1[1]); w.w = cvt_pk_bf16(v1[2], v1[3]);
                    *(u32x4*)(rowp + bj * HALF) = w;
#endif
                } }
    }
};
struct EpiInProj {
    bf16_t* QKVb; const float* gq; const float* gk; const float* rope; float sc;
    __device__ __forceinline__ void operator()(const f32x4 (&acc)[2][2][4][2], const Unit& u, int wr, int wc, int fr, int fq) const {
        const int it = u.pm % 17, pn = u.pn; const bool isctx = (it == 16);
        const int row0 = u.pm * BM + wr * 64 + fr;
        const bool headed = (pn < 2) || (pn == 2 && wc < 2);
        if (!headed) {
            bf16_t* base; int ldc, col, bjs;
            if (pn == 2) { base = QKVb + O_VA; ldc = 128; col = (wc - 2) * 64 + 8 * fq; bjs = 32; }
            else if (pn <= 4) { base = QKVb + O_VRI; ldc = 512; col = (pn - 3) * 256 + wc * 32 + 8 * fq; bjs = 128; }
            else { base = QKVb + (pn == 5 ? O_QN : (pn == 6 ? O_KN : O_VN)); ldc = 256; col = wc * 32 + 8 * fq; bjs = 128; }
#pragma unroll
            for (int ai = 0; ai < 2; ++ai)
#pragma unroll
                for (int m = 0; m < 4; ++m) { bf16_t* rowp = base + (size_t)(row0 + ai * HALF + m * 16) * ldc + col;
#pragma unroll
                    for (int bj = 0; bj < 2; ++bj) { const f32x4 v0 = acc[ai][bj][m][0] * sc, v1 = acc[ai][bj][m][1] * sc;
                        if ((ATT_F8 && (pn == 5 || pn == 6)) || (PV_F8 && (pn == 2 || pn == 7))) { u32x2 w8; w8.x = pk4_fp8(v0[0], v0[1], v0[2], v0[3]); w8.y = pk4_fp8(v1[0], v1[1], v1[2], v1[3]);
                            *(u32x2*)((unsigned char*)base + ((size_t)(row0 + ai * HALF + m * 16) * ldc + col + bj * bjs)) = w8; }
                        else {
                        u32x4 w; w.x = cvt_pk_bf16(v0[0], v0[1]); w.y = cvt_pk_bf16(v0[2], v0[3]); w.z = cvt_pk_bf16(v1[0], v1[1]); w.w = cvt_pk_bf16(v1[2], v1[3]);
                        *(u32x4*)(rowp + bj * bjs) = w; } } }
        } else {
            const bool isq = pn < 2; const float* g = isq ? gq : gk;
            bf16_t* base = QKVb + (isq ? O_QA : O_KA); const int ldc = isq ? 512 : 128; const int col = (isq ? (pn * 4 + wc) : wc) * 64 + 8 * fq;
            const int lanev = fq * 16 + fr; const float qs = isq ? C2 : 1.0f; const bool hi_half = (fq >> 1) != 0;
            f32x4 gv[2][2];
#pragma unroll
            for (int bj = 0; bj < 2; ++bj)
#pragma unroll
                for (int n = 0; n < 2; ++n) gv[bj][n] = *(const f32x4*)(g + 32 * bj + 8 * fq + 4 * n);
            f32x4 rco[2][2], rsi[2][2];
            if (!isctx) {
#pragma unroll
                for (int ai = 0; ai < 2; ++ai) { const int pos = it * 4 + ai * 2 + wr;
#pragma unroll
                    for (int n = 0; n < 2; ++n) { const float* cs = rope + (pos * 16 + 8 * (fq & 1) + 4 * n) * 2; const f32x4 c01 = *(const f32x4*)cs, c23 = *(const f32x4*)(cs + 4);
                        rco[ai][n] = (f32x4){c01.x, c01.z, c23.x, c23.z}; const f32x4 sv = (f32x4){c01.y, c01.w, c23.y, c23.w}; rsi[ai][n] = hi_half ? sv : -sv; } } }
#pragma unroll
            for (int m = 0; m < 4; ++m) {
                f32x4 cco[2], csi[2];
                if (!isctx) { const int pos = m * 16 + fr;
#pragma unroll
                    for (int n = 0; n < 2; ++n) { const float* cs = rope + (pos * 16 + 8 * (fq & 1) + 4 * n) * 2; const f32x4 c01 = *(const f32x4*)cs, c23 = *(const f32x4*)(cs + 4);
                        cco[n] = (f32x4){c01.x, c01.z, c23.x, c23.z}; const f32x4 sv = (f32x4){c01.y, c01.w, c23.y, c23.w}; csi[n] = hi_half ? sv : -sv; } }
#pragma unroll
                for (int ai = 0; ai < 2; ++ai) {
                    f32x4 v[2][2]; float ss = 0.f;
#pragma unroll
                    for (int bj = 0; bj < 2; ++bj)
#pragma unroll
                        for (int n = 0; n < 2; ++n) { const f32x4 a_ = acc[ai][bj][m][n]; ss += (a_[0] * a_[0] + a_[1] * a_[1]) + (a_[2] * a_[2] + a_[3] * a_[3]); v[bj][n] = a_ * gv[bj][n]; }
                    ss += shx(ss, 16, lanev); ss += shx(ss, 32, lanev);
                    const float R = (sc * qs) / sqrtf(ss * (sc * sc * (1.f / 64.f)) + EPS);
                    if (!isctx) {
#pragma unroll
                        for (int bj = 0; bj < 2; ++bj)
#pragma unroll
                            for (int n = 0; n < 2; ++n) { const f32x4 co = (bj == 0) ? rco[ai][n] : cco[n], si = (bj == 0) ? rsi[ai][n] : csi[n];
#pragma unroll
                                for (int j = 0; j < 4; ++j) { const float own = v[bj][n][j];
                                    auto sw = __builtin_amdgcn_permlane32_swap(__builtin_bit_cast(unsigned, own), __builtin_bit_cast(unsigned, own), false, false);
                                    const float oth = __builtin_bit_cast(float, hi_half ? sw[0] : sw[1]);
                                    v[bj][n][j] = own * co[j] + oth * si[j]; } } }
#pragma unroll
                    for (int bj = 0; bj < 2; ++bj) { const f32x4 v0 = v[bj][0] * R, v1 = v[bj][1] * R;
#if ATT_F8
                        u32x2 w8; w8.x = pk4_fp8(v0[0], v0[1], v0[2], v0[3]); w8.y = pk4_fp8(v1[0], v1[1], v1[2], v1[3]);
                        *(u32x2*)((unsigned char*)base + ((size_t)(row0 + ai * HALF + m * 16) * ldc + col + bj * 32)) = w8;
#else
                        bf16_t* rowp = base + (size_t)(row0 + ai * HALF + m * 16) * ldc + col;
                        u32x4 w; w.x = cvt_pk_bf16(v0[0], v0[1]); w.y = cvt_pk_bf16(v0[2], v0[3]); w.z = cvt_pk_bf16(v1[0], v1[1]); w.w = cvt_pk_bf16(v1[2], v1[3]);
                        *(u32x4*)(rowp + bj * 32) = w;
#endif
                    } } }
        }
    }
};
struct EpiSwiGLU {
    bf16_t* O;
    __device__ __forceinline__ void operator()(const f32x4 (&acc)[2][2][4][2], const Unit& u, int wr, int wc, int fr, int fq) const {
        const int row0 = u.pm * BM + wr * 64 + fr, col0 = u.pn * HALF + wc * 32 + 8 * fq;
#pragma unroll
        for (int ai = 0; ai < 2; ++ai)
#pragma unroll
            for (int m = 0; m < 4; ++m) { bf16_t* rowp = O + (size_t)(row0 + ai * HALF + m * 16) * FF + col0;
                float r[8];
#pragma unroll
                for (int n = 0; n < 2; ++n)
#pragma unroll
                    for (int j = 0; j < 4; ++j) { const float gt = acc[ai][0][m][n][j], up = acc[ai][1][m][n][j];
                        const float sg = gt * __builtin_amdgcn_rcpf(1.0f + __builtin_amdgcn_exp2f(-gt * LOG2E)); r[n * 4 + j] = sg * up; }
                u32x4 w; w.x = cvt_pk_bf16(r[0], r[1]); w.y = cvt_pk_bf16(r[2], r[3]); w.z = cvt_pk_bf16(r[4], r[5]); w.w = cvt_pk_bf16(r[6], r[7]);
                *(u32x4*)rowp = w; }
    }
};
struct EpiSwiGLU8 {
    unsigned char* O; float sc;
    __device__ __forceinline__ void operator()(const f32x4 (&acc)[2][2][4][2], const Unit& u, int wr, int wc, int fr, int fq) const {
        const int row0 = u.pm * BM + wr * 64 + fr, col0 = u.pn * HALF + wc * 32 + 8 * fq;
#pragma unroll
        for (int ai = 0; ai < 2; ++ai)
#pragma unroll
            for (int m = 0; m < 4; ++m) { unsigned char* rowp = O + (size_t)(row0 + ai * HALF + m * 16) * FF + col0;
                float r[8];
#pragma unroll
                for (int n = 0; n < 2; ++n)
#pragma unroll
                    for (int j = 0; j < 4; ++j) { const float ga_ = acc[ai][0][m][n][j], ua_ = acc[ai][1][m][n][j];
                        const float q_ = __builtin_amdgcn_rcpf(1.0f + __builtin_amdgcn_exp2f(ga_ * (-sc * LOG2E))); r[n * 4 + j] = (ga_ * ua_) * (q_ * (sc * sc)); }
                u32x2 w; w.x = pk4_fp8(r[0], r[1], r[2], r[3]); w.y = pk4_fp8(r[4], r[5], r[6], r[7]);
                *(u32x2*)rowp = w; }
    }
};
struct EpiResid {
    bf16_t* Xs; const float* gate  ; float gsc; const LAS float* rs3;
    __device__ __forceinline__ void operator()(const f32x4 (&acc)[2][2][4][2], const Unit& u, int wr, int wc, int fr, int fq) const {
        const int b = u.pm / 17, it = u.pm % 17; const bool isctx = (it == 16);
        const float* gp = gate + (size_t)(isctx ? 8 : b) * 6144;
        const int col0 = u.pn * BM + wc * 32 + 8 * fq;
        bf16_t* base = Xs + ((size_t)u.pm * BM + wr * 64 + fr) * DM + col0;
        u32x4 xw[2][4][2];
#pragma unroll
        for (int ai = 0; ai < 2; ++ai)
#pragma unroll
            for (int m = 0; m < 4; ++m)
#pragma unroll
                for (int bj = 0; bj < 2; ++bj) xw[ai][m][bj] = *(const u32x4*)(base + (size_t)(ai * HALF + m * 16) * DM + bj * HALF);
        f32x4 g0[2], g1[2];
#pragma unroll
        for (int bj = 0; bj < 2; ++bj) { g0[bj] = *(const f32x4*)(gp + col0 + bj * HALF); g1[bj] = *(const f32x4*)(gp + col0 + bj * HALF + 4); }
#pragma unroll
        for (int ai = 0; ai < 2; ++ai)
#pragma unroll
            for (int m = 0; m < 4; ++m) { const int rr = ai * HALF + wr * 64 + m * 16 + fr; const float f3 = gsc * rs3[rr * 3];
#pragma unroll
                for (int bj = 0; bj < 2; ++bj) { const u32x4 xv = xw[ai][m][bj];
                    const f32x4 x0 = (f32x4){bflo(xv.x), bfhi(xv.x), bflo(xv.y), bfhi(xv.y)}, x1 = (f32x4){bflo(xv.z), bfhi(xv.z), bflo(xv.w), bfhi(xv.w)};
                    const f32x4 y0 = x0 + g0[bj] * f3 * acc[ai][bj][m][0], y1 = x1 + g1[bj] * f3 * acc[ai][bj][m][1];
                    u32x4 w; w.x = cvt_pk_bf16(y0[0], y0[1]); w.y = cvt_pk_bf16(y0[2], y0[3]); w.z = cvt_pk_bf16(y1[0], y1[1]); w.w = cvt_pk_bf16(y1[2], y1[3]);
                    *(u32x4*)(base + (size_t)(ai * HALF + m * 16) * DM + bj * HALF) = w; } }
    }
};
}

namespace attn {
using bf16 = __hip_bfloat16;
constexpr int NW = 8, QBLK = 32, KVBLK = 64;
constexpr int OP = DM;
__device__ __forceinline__ int crow(int r, int hi) { return (r & 3) + 8 * (r >> 2) + 4 * hi; }
#define SBAR() __builtin_amdgcn_sched_barrier(0)
constexpr int NSLOT = 3, SLOTB = 8192;
constexpr int LDS_K = 0, LDS_V = NSLOT * SLOTB, LDS_WS = 2 * NSLOT * SLOTB, LDS_OST = LDS_WS + NW * 64 * 4, LDS_BYTES = LDS_OST + NW * 4096;
constexpr int LDS_RB = 86016;
constexpr int LDS_KSCR = 98304;
__device__ __forceinline__ void glds16(const void* gsrc, unsigned lds_dst) { unsigned keep;
  asm volatile("s_mov_b32 %0, m0\n\ts_mov_b32 m0, %2\n\ts_nop 0\n\tglobal_load_lds_dwordx4 %1, off\n\ts_mov_b32 m0, %0" : "=&s"(keep) : "v"(gsrc), "s"(lds_dst) : "memory"); }
__device__ __forceinline__ float max3f(float a, float b, float c) { float r; asm("v_max3_f32 %0, %1, %2, %3" : "=v"(r) : "v"(a), "v"(b), "v"(c)); return r; }
__device__ __forceinline__ float max2f(float a, float b) { float r; asm("v_max_f32_e32 %0, %1, %2" : "=v"(r) : "v"(a), "v"(b)); return r; }
__device__ __forceinline__ float fadd_s(float a, float b) { float r; asm("v_add_f32_e32 %0, %1, %2" : "=v"(r) : "v"(a), "v"(b)); return r; }
__device__ __forceinline__ float fsub_s(float a, float b) { float r; asm("v_sub_f32_e32 %0, %1, %2" : "=v"(r) : "v"(a), "v"(b)); return r; }
typedef __bf16 bf16x2_t __attribute__((ext_vector_type(2)));
__device__ __forceinline__ unsigned cvtpk_s(float lo, float hi) { f32x2 v = {lo, hi}; bf16x2_t b = __builtin_convertvector(v, bf16x2_t); return __builtin_bit_cast(unsigned, b); }
#define WAIT_BAR(N) asm volatile("s_waitcnt vmcnt(" #N ") lgkmcnt(0)\n\ts_barrier" ::: "memory")
#if PV_F8 && DMA_ROLES
#define WAIT_STEADY() WAIT_BAR(1)
#else
#define WAIT_STEADY() WAIT_BAR(2)
#endif
__device__ __forceinline__ void qkt(f32x16& p0, f32x16& p1, const char* Kslot, const bf16x8* qr, const f32x16& negm, int r32, int hi) {
  const char* kb = Kslot + hi * 1024 + r32 * 16;
#pragma unroll
  for (int d0 = 0; d0 < 4; ++d0) {
    const bf16x8 b0 = *reinterpret_cast<const bf16x8*>(kb + d0 * 2048);
    const bf16x8 b1 = *reinterpret_cast<const bf16x8*>(kb + d0 * 2048 + 512);
    if (d0 == 0) { p0 = __builtin_amdgcn_mfma_f32_32x32x16_bf16(b0, qr[0], negm, 0, 0, 0); p1 = __builtin_amdgcn_mfma_f32_32x32x16_bf16(b1, qr[0], negm, 0, 0, 0); }
    else { p0 = __builtin_amdgcn_mfma_f32_32x32x16_bf16(b0, qr[d0], p0, 0, 0, 0); p1 = __builtin_amdgcn_mfma_f32_32x32x16_bf16(b1, qr[d0], p1, 0, 0, 0); } }
}
typedef LAS const char* lds_cptr;
typedef short v4i16_t __attribute__((ext_vector_type(4)));
__device__ __forceinline__ void kload8(bf16x8* kf, lds_cptr kp) {
  kf[0] = *(const LAS bf16x8*)(kp);        kf[1] = *(const LAS bf16x8*)(kp + 512);
  kf[2] = *(const LAS bf16x8*)(kp + 2048); kf[3] = *(const LAS bf16x8*)(kp + 2560);
  kf[4] = *(const LAS bf16x8*)(kp + 4096); kf[5] = *(const LAS bf16x8*)(kp + 4608);
  kf[6] = *(const LAS bf16x8*)(kp + 6144); kf[7] = *(const LAS bf16x8*)(kp + 6656);
}
__device__ __forceinline__ void kload2(bf16x8* kf, lds_cptr kp, int j) { kf[2 * j] = *(const LAS bf16x8*)(kp + j * 2048); kf[2 * j + 1] = *(const LAS bf16x8*)(kp + j * 2048 + 512); }
__device__ __forceinline__ s16x4 vtr(lds_cptr p) { return __builtin_bit_cast(s16x4, __builtin_amdgcn_ds_read_tr16_b64_v4i16((LAS v4i16_t*)p)); }
__device__ __forceinline__ float rowmax(const f32x16& p0, const f32x16& p1) {
  float a = max3f(p0[0], p0[1], p1[0]), b = max3f(p0[2], p0[3], p1[1]); a = max3f(a, p1[2], p1[3]);
#pragma unroll
  for (int r = 4; r < 16; r += 4) { a = max3f(a, p0[r], p0[r + 1]); b = max3f(b, p0[r + 2], p0[r + 3]); a = max3f(a, p1[r], p1[r + 1]); b = max3f(b, p1[r + 2], p1[r + 3]); }
  const float m = max2f(a, b);
  auto rr = __builtin_amdgcn_permlane32_swap(__float_as_uint(m), __float_as_uint(m), false, false);
  return max2f(__uint_as_float(rr[0]), __uint_as_float(rr[1]));
}
__device__ __forceinline__ void pv(f32x16* o, int vb, bf16x8 pa0, bf16x8 pa1, bf16x8 pa2, bf16x8 pa3) {
#pragma unroll
  for (int d0 = 0; d0 < 2; ++d0) { s16x4 lo[4], hi[4];
#pragma unroll
    for (int ks = 0; ks < 4; ++ks) {
      asm volatile("ds_read_b64_tr_b16 %0,%1 offset:%c2" : "=&v"(lo[ks]) : "v"(vb), "i"(d0 * 4096 + ks * 1024) : "memory");
      asm volatile("ds_read_b64_tr_b16 %0,%1 offset:%c2" : "=&v"(hi[ks]) : "v"(vb), "i"(d0 * 4096 + ks * 1024 + 512) : "memory"); }
    asm volatile("s_waitcnt lgkmcnt(0)" ::: "memory"); SBAR();
#define PK(k) (bf16x8){lo[k][0], lo[k][1], lo[k][2], lo[k][3], hi[k][0], hi[k][1], hi[k][2], hi[k][3]}
    o[d0] = __builtin_amdgcn_mfma_f32_32x32x16_bf16(pa0, PK(0), o[d0], 0, 0, 0);
    o[d0] = __builtin_amdgcn_mfma_f32_32x32x16_bf16(pa1, PK(1), o[d0], 0, 0, 0);
    o[d0] = __builtin_amdgcn_mfma_f32_32x32x16_bf16(pa2, PK(2), o[d0], 0, 0, 0);
    o[d0] = __builtin_amdgcn_mfma_f32_32x32x16_bf16(pa3, PK(3), o[d0], 0, 0, 0);
#undef PK
  }
}
template <bool NA> __device__ __forceinline__ void na_hook(f32x16& P0, f32x16& P1, int t, int T0, int n_win, int kr_lo, int qr, int c, int hi, const LAS float* rb) {
  if constexpr (NA) {
    if (t >= T0) {
      const int w = t - T0, kr = kr_lo + w;
      int rs = qr - 4; rs = rs < 0 ? 0 : (rs > 56 ? 56 : rs);
      const bool rowok = (w < n_win) && (kr >= rs) && (kr < rs + 8);
      if (!rowok) {
#pragma unroll
        for (int r = 0; r < 16; ++r) { P0[r] = -INFINITY; P1[r] = -INFINITY; }
      } else {
        int cs = c - 8; cs = cs < 0 ? 0 : (cs > 48 ? 48 : cs);
        const LAS float* rbp = rb + (kr - qr + 7) * 128 + (63 - c) + 4 * hi;
        const int d0 = 4 * hi - cs;
#pragma unroll
        for (int r = 0; r < 16; ++r) { const int kc0 = (r & 3) + 8 * (r >> 2);
          const float b0 = rbp[kc0], b1 = rbp[kc0 + 32];
          P0[r] = ((unsigned)(kc0 + d0) < 16u) ? P0[r] + b0 : -INFINITY;
          P1[r] = ((unsigned)(kc0 + 32 + d0) < 16u) ? P1[r] + b1 : -INFINITY; }
      }
    }
  }
}
template <int THRL, bool NA, int QP, int KP> __device__ __forceinline__ void attn_unit(const bf16* Qw0, const bf16* __restrict__ Kh, const bf16* __restrict__ Vh, bf16* Ow0, char* shm,
                                                                        int NT, int T0, int row0, int row1, int nvalid, int qr0, int kr_lo, int n_win, float* st0  ) {
  const int tid = tid_fresh(), lane = tid & 63, r32 = lane & 31, hi = lane >> 5; const int wid = __builtin_amdgcn_readfirstlane(tid >> 6);
  const bf16* Qw = Qw0 + (long)(wid * QBLK) * QP;
  const unsigned lds0 = (unsigned)(uintptr_t)shm;
  float* wsf = (float*)(shm + LDS_WS) + wid * 64;
#if ATT_F8
  const unsigned char* Qw8 = (const unsigned char*)Qw0 + (long)(wid * QBLK) * QP;
  const unsigned char* ksrc = (const unsigned char*)Kh + (long)lane * KP + (wid & 3) * 16;
#else
  const bf16* ksrc = Kh + (long)lane * KP + wid * 8;
#endif
#if PV_F8
  const int vrho_ = 16 * (wid & 3) + (lane >> 2), vkey_ = 16 * ((vrho_ >> 3) & 3) + 8 * ((vrho_ & 7) >> 2) + 4 * (vrho_ >> 5) + (vrho_ & 3);
  const unsigned char* vsrc = (const unsigned char*)Vh + (long)vkey_ * KP + (lane & 3) * 16;
#else
  const bf16* vsrc = Vh + (long)(16 * (wid & 3) + (lane >> 2)) * KP + (wid >> 2) * 32 + (lane & 3) * 8;
#endif
#if ATT_F8
  const int kslotm = (wid < 4) ? -1 : 0;
  const unsigned kdst = lds0 + (wid < 4 ? LDS_K + wid * 1024 : LDS_KSCR + (wid & 3) * 1024);
#if PV_F8 && DMA_ROLES
  const unsigned vdst = lds0 + LDS_V + (wid & 3) * 1024;
#elif PV_F8
  const unsigned vdst = lds0 + (wid < 4 ? LDS_V + wid * 1024 : LDS_KSCR + 4096 + (wid & 3) * 1024);
#else
  const unsigned vdst = lds0 + LDS_V + wid * 1024;
#endif
#else
  const unsigned kdst = lds0 + LDS_K + wid * 1024, vdst = lds0 + LDS_V + wid * 1024;
#endif
#define TROW(t) (!NA ? row0 + 64 * (t) : ((t) < T0 ? row0 + 64 * (t) : row1 + 64 * ((((t) < nvalid) ? (t) : nvalid - 1) - T0)))
#if ATT_F8 && PV_F8 && DMA_ROLES
#define DMA_K(t, slot) do { if (wid < 4) glds16(ksrc + (long)TROW(t) * KP, (unsigned)__builtin_amdgcn_readfirstlane(kdst + (slot))); } while (0)
#elif ATT_F8
#define DMA_K(t, slot) glds16(ksrc + (long)TROW(t) * KP, (unsigned)__builtin_amdgcn_readfirstlane(kdst + ((slot) & kslotm)))
#else
#define DMA_K(t, slot) glds16(ksrc + (long)TROW(t) * KP, (unsigned)__builtin_amdgcn_readfirstlane(kdst + (slot)))
#endif
#if PV_F8 && DMA_ROLES
#define DMA_V(t, slot) do { if (wid >= 4) glds16(vsrc + (long)TROW(t) * KP, (unsigned)__builtin_amdgcn_readfirstlane(vdst + (slot))); } while (0)
#elif PV_F8
#define DMA_V(t, slot) glds16(vsrc + (long)TROW(t) * KP, (unsigned)__builtin_amdgcn_readfirstlane(vdst + ((slot) & kslotm)))
#else
#define DMA_V(t, slot) glds16(vsrc + (long)TROW(t) * KP, (unsigned)__builtin_amdgcn_readfirstlane(vdst + (slot)))
#endif
  const int vb0 = (int)(lds0 + LDS_V) + ((lane >> 4) & 1) * 32 + (lane & 3) * 8 + (4 * hi + ((lane & 15) >> 2)) * 64;
#if ATT_F8
  i32x8v k8[2];
  const lds_cptr shm3 = (lds_cptr)shm; const lds_cptr kp0 = shm3 + LDS_K + hi * 2048 + r32 * 16;
#if PV_F8
  const lds_cptr vp0 = shm3 + LDS_V + (32 * hi + ((lane & 15) >> 1)) * 64 + ((lane >> 4) & 1) * 16 + (lane & 1) * 8;
#else
  const lds_cptr vp0 = shm3 + LDS_V + ((lane >> 4) & 1) * 32 + (lane & 3) * 8 + (4 * hi + ((lane & 15) >> 2)) * 64;
#endif
#define K8LD(dst, kp_, s_) dst = __builtin_shufflevector(*(const LAS i32x4v*)((kp_) + (s_) * 512), *(const LAS i32x4v*)((kp_) + 1024 + (s_) * 512), 0, 1, 2, 3, 4, 5, 6, 7)
#define QK8(kk, cc) __builtin_amdgcn_mfma_scale_f32_32x32x64_f8f6f4(kk, q8, cc, 0, 0, 0, 0, 0, 0)
#else
  const char* Kbase = shm + LDS_K; bf16x8 kf[8];
  const lds_cptr shm3 = (lds_cptr)shm; const lds_cptr kp0 = shm3 + LDS_K + hi * 1024 + r32 * 16;
  const lds_cptr vp0 = shm3 + LDS_V + ((lane >> 4) & 1) * 32 + (lane & 3) * 8 + (4 * hi + ((lane & 15) >> 2)) * 64;
#endif
  const LAS float* rb = (const LAS float*)(shm3 + LDS_RB);
  const int qr = qr0 + (wid >> 1), qc = 32 * (wid & 1) + r32;
  DMA_K(0, 0); DMA_V(0, 0); DMA_K(1, SLOTB);
#if ATT_F8
  const i32x8v q8 = __builtin_shufflevector(*(const i32x4v*)(Qw8 + (long)r32 * QP + hi * 32), *(const i32x4v*)(Qw8 + (long)r32 * QP + hi * 32 + 16), 0, 1, 2, 3, 4, 5, 6, 7);
#else
  bf16x8 qrg[4];
#pragma unroll
  for (int d0 = 0; d0 < 4; ++d0) qrg[d0] = *reinterpret_cast<const bf16x8*>(&Qw[(long)r32 * QP + d0 * 16 + hi * 8]);
#endif
  float mhat = 0.f; f32x16 o[2]; o[0] = f32x16{}; o[1] = f32x16{}; f32x16 negm = f32x16{}; asm volatile("" : "+v"(negm));
  f32x4 lacc = (f32x4){0.f, 0.f, 0.f, 0.f};
  const unsigned osel_ = ((((lane >> 4) & 1) == 0) == ((lane & 15) < 8)) ? 0x3F803F80u : 0u;
  const bf16x8 ones = __builtin_bit_cast(bf16x8, (u32x4){osel_, osel_, osel_, osel_});
#define LROW0() ({ int ll_ = lane; asm volatile("" : "+v"(ll_)); 4 * (ll_ >> 4) + (((ll_ & 15) >= 8) ? 16 : 0); })
#define CMASK(P0, P1, t) na_hook<NA>(P0, P1, (t), T0, n_win, kr_lo, qr, qc, hi, rb)
  bool resc = false;
#define START(P0, P1) do { const float rm = rowmax(P0, P1); resc = false; \
    { const float dl = rm; mhat = fadd_s(mhat, dl); \
      _Pragma("unroll") for (int r = 0; r < 16; ++r) { P0[r] = fsub_s(P0[r], dl); P1[r] = fsub_s(P1[r], dl); } \
      _Pragma("unroll") for (int r = 0; r < 16; ++r) negm[r] = -mhat; asm volatile("" : "+v"(negm)); } \
    _Pragma("unroll") for (int r = 0; r < 16; ++r) P0[r] = __builtin_amdgcn_exp2f(P0[r]); } while (0)
#define RESC() do { if (resc) { asm volatile("s_waitcnt lgkmcnt(0)" ::: "memory"); \
      _Pragma("unroll") for (int d_ = 0; d_ < 2; ++d_) _Pragma("unroll") for (int r = 0; r < 16; ++r) o[d_][r] *= wsf[crow(r, hi)]; \
      { const int lr0_ = LROW0(); _Pragma("unroll") for (int r = 0; r < 4; ++r) lacc[r] *= wsf[lr0_ + r]; } } } while (0)
  f32x16 pA0, pA1, pB0, pB1;
  int sl_prev = 0, sl_cur = 0, sl_next = SLOTB;
#define ROT() do { sl_prev = sl_cur; sl_cur = sl_next; sl_next = (sl_next == (NSLOT - 1) * SLOTB) ? 0 : sl_next + SLOTB; } while (0)
  DMA_K(2, 2 * SLOTB);
#if PV_F8 && DMA_ROLES
  WAIT_BAR(2);
#else
  WAIT_BAR(3);
#endif
#if ATT_F8
  K8LD(k8[0], kp0, 0); K8LD(k8[1], kp0, 1); pA0 = QK8(k8[0], negm); pA1 = QK8(k8[1], negm);
#else
  qkt(pA0, pA1, Kbase, qrg, negm, r32, hi);
#endif
  asm volatile("s_nop 15\n\ts_nop 7" : "+v"(pA0), "+v"(pA1)); CMASK(pA0, pA1, 0);
  START(pA0, pA1);
  _Pragma("unroll") for (int r = 0; r < 16; ++r) pA1[r] = __builtin_amdgcn_exp2f(pA1[r]);
  WAIT_BAR(0);
  DMA_K(3, 0); DMA_V(1, SLOTB);
  ROT();
#if ATT_F8
  K8LD(k8[0], kp0 + sl_cur, 0); K8LD(k8[1], kp0 + sl_cur, 1);
#else
  kload8(kf, kp0 + sl_cur);
#endif
  WAIT_BAR(2);
#if PV_F8
  i32x2v vv[8]; u32x4 p8lo, p8hi;
  const unsigned s8_ = osel_ ? 0x38383838u : 0u; const i32x8v sel8 = (i32x8v){(int)s8_, (int)s8_, (int)s8_, (int)s8_, (int)s8_, (int)s8_, (int)s8_, (int)s8_};
#define PK4(P, B) pk4_fp8(P[B], P[B + 1], P[B + 2], P[B + 3])
#define P8() __builtin_shufflevector(__builtin_bit_cast(i32x4v, p8lo), __builtin_bit_cast(i32x4v, p8hi), 0, 1, 2, 3, 4, 5, 6, 7)
#define V8(d0) ((i32x8v){vv[4 * (d0)][0], vv[4 * (d0)][1], vv[4 * (d0) + 1][0], vv[4 * (d0) + 1][1], vv[4 * (d0) + 2][0], vv[4 * (d0) + 2][1], vv[4 * (d0) + 3][0], vv[4 * (d0) + 3][1]})
#define PVM(d0) o[d0] = __builtin_amdgcn_mfma_scale_f32_32x32x64_f8f6f4(P8(), V8(d0), o[d0], 0, 0, 0, 0, 0, 0)
#define LSUM() __builtin_amdgcn_mfma_scale_f32_16x16x128_f8f6f4(P8(), sel8, lacc, 0, 0, 0, 0, 0, 0)
#define GAPA8(MF, W0, PW) do { MF; W0; PIN(PW); SBAR(); } while (0)
#else
  s16x4 vlo[8], vhi[8]; u32x4 pw0, pw1, pw2, pw3;
#endif
#define PKW(P, B) cvtpk_s(P[B], P[B + 1])
#define PAF(k) __builtin_bit_cast(bf16x8, pw##k)
#define VFR(i) (bf16x8){vlo[i][0], vlo[i][1], vlo[i][2], vlo[i][3], vhi[i][0], vhi[i][1], vhi[i][2], vhi[i][3]}
#define PIN(x) asm volatile("" : "+v"(x))
#define MX3(a, b, c) __builtin_fmaxf(__builtin_fmaxf((a), (b)), (c))
#define GAPA(MF, A0, A1, A2, A3, W0, W1, PW) do { MF; W0; W1; PIN(PW); SBAR(); } while (0)
#define EX(v) __builtin_amdgcn_exp2f(v)
#define GAPB(MF, X, B) do { MF; X[B] = EX(X[B]); X[B + 1] = EX(X[B + 1]); X[B + 2] = EX(X[B + 2]); X[B + 3] = EX(X[B + 3]); PIN(X); SBAR(); } while (0)
#if PV_F8
#define VRD(i) vv[i] = __builtin_amdgcn_ds_read_tr8_b64_v2i32((LAS i32x2v*)(vp_ + (((i) >> 2) * 32 + ((i) & 3) * 512)))
#else
#define VRD(i) do { vlo[i] = vtr(vp_ + (((i) >> 2) * 4096 + ((i) & 3) * 1024)); vhi[i] = vtr(vp_ + (((i) >> 2) * 4096 + ((i) & 3) * 1024 + 512)); } while (0)
#endif
#if ATT_F8
#define KRD(G, j) do { if ((G) && (j) < 2) { K8LD(k8[j], kp0 + sl_next, j); SBAR(); } } while (0)
#define QKM(C, i, acc_) do { if ((i) == 0) C = QK8(k8[0], negm); else if ((i) == 1) C = QK8(k8[1], negm); } while (0)
#else
#define KRD(G, j) do { if (G) { kload2(kf, kp0 + sl_next, j); SBAR(); } } while (0)
#define QKM(C, i, acc_) C = __builtin_amdgcn_mfma_f32_32x32x16_bf16(kf[i], qrg[(i) >> 1], acc_, 0, 0, 0)
#endif
#if PV_F8
#define STEP(C0, C1, P0, P1, t, GK, GV, GL) do { SBAR(); \
    const lds_cptr vp_ = vp0 + sl_prev; \
    VRD(0); SBAR(); GAPA8(QKM(C0, 0, negm), p8lo[0] = PK4(P0, 0), p8lo); \
    VRD(4); SBAR(); GAPA8(QKM(C1, 1, negm), p8lo[1] = PK4(P0, 4), p8lo); \
    VRD(1); SBAR(); GAPA8((void)0, p8lo[2] = PK4(P0, 8), p8lo); \
    VRD(5); SBAR(); GAPA8((void)0, p8lo[3] = PK4(P0, 12), p8lo); \
    VRD(2); SBAR(); GAPA8((void)0, p8hi[0] = PK4(P1, 0), p8hi); \
    VRD(6); SBAR(); GAPA8((void)0, p8hi[1] = PK4(P1, 4), p8hi); \
    VRD(3); SBAR(); GAPA8((void)0, p8hi[2] = PK4(P1, 8), p8hi); \
    VRD(7); SBAR(); GAPA8((void)0, p8hi[3] = PK4(P1, 12), p8hi); \
    if (GK) { DMA_K((t) + 3, sl_cur); } if (GV) { DMA_V((t) + 1, sl_next); } \
    CMASK(C0, C1, t); \
    { float a = MX3(C0[0], C0[1], C1[0]), b = MX3(C0[2], C0[3], C1[1]); a = MX3(a, C1[2], C1[3]); \
      _Pragma("unroll") for (int r = 4; r < 16; r += 4) { a = MX3(a, C0[r], C0[r + 1]); b = MX3(b, C0[r + 2], C0[r + 3]); a = MX3(a, C1[r], C1[r + 1]); b = MX3(b, C1[r + 2], C1[r + 3]); } \
      float rm = __builtin_fmaxf(a, b); { auto rr = __builtin_amdgcn_permlane32_swap(__float_as_uint(rm), __float_as_uint(rm), false, false); rm = __builtin_fmaxf(__uint_as_float(rr[0]), __uint_as_float(rr[1])); } \
      resc = false; \
      if (__builtin_expect(__any(rm > (float)THRL), 0)) { const float dl = __builtin_fmaxf(rm, 0.f); mhat += dl; \
        _Pragma("unroll") for (int r = 0; r < 16; ++r) { C0[r] -= dl; C1[r] -= dl; } \
        _Pragma("unroll") for (int r = 0; r < 16; ++r) negm[r] = -mhat; asm volatile("" : "+v"(negm)); \
        const float f = __builtin_amdgcn_exp2f(-dl); if (hi == 0) wsf[r32] = f; resc = true; } } \
    SBAR(); \
    GAPB(PVM(0), C0, 0); \
    GAPB(lacc = LSUM(), C0, 4); \
    KRD(GL, 0); GAPB((void)0, C0, 8); \
    KRD(GL, 1); GAPB((void)0, C0, 12); \
    GAPB(PVM(1), C1, 0); \
    GAPB((void)0, C1, 4); \
    GAPB((void)0, C1, 8); \
    GAPB((void)0, C1, 12); \
    } while (0)
#else
#define STEP(C0, C1, P0, P1, t, GK, GV, GL) do { SBAR(); \
    const lds_cptr vp_ = vp0 + sl_prev; \
    VRD(0); SBAR(); \
    GAPA(QKM(C0, 0, negm), P0[2], P0[3], P0[4], P0[5],     pw0[0] = PKW(P0, 0), pw0[1] = PKW(P0, 2), pw0); \
    VRD(4); SBAR(); GAPA(QKM(C1, 1, negm), P0[6], P0[7], P0[8], P0[9],     pw0[2] = PKW(P0, 4), pw0[3] = PKW(P0, 6), pw0); \
    VRD(1); SBAR(); GAPA(QKM(C0, 2, C0),   P0[10], P0[11], P0[12], P0[13], pw1[0] = PKW(P0, 8), pw1[1] = PKW(P0, 10), pw1); \
    VRD(5); SBAR(); GAPA(QKM(C1, 3, C1),   P0[14], P0[15], P1[0], P1[1],   pw1[2] = PKW(P0, 12), pw1[3] = PKW(P0, 14), pw1); \
    VRD(2); SBAR(); GAPA(QKM(C0, 4, C0),   P1[2], P1[3], P1[4], P1[5],     pw2[0] = PKW(P1, 0), pw2[1] = PKW(P1, 2), pw2); \
    VRD(6); SBAR(); GAPA(QKM(C1, 5, C1),   P1[6], P1[7], P1[8], P1[9],     pw2[2] = PKW(P1, 4), pw2[3] = PKW(P1, 6), pw2); \
    VRD(3); SBAR(); GAPA(QKM(C0, 6, C0),   P1[10], P1[11], P1[12], P1[13], pw3[0] = PKW(P1, 8), pw3[1] = PKW(P1, 10), pw3); \
    VRD(7); SBAR(); GAPA(QKM(C1, 7, C1),   P1[14], P1[15], 0.f, 0.f,       pw3[2] = PKW(P1, 12), pw3[3] = PKW(P1, 14), pw3); \
    if (GK) { DMA_K((t) + 3, sl_cur); } if (GV) { DMA_V((t) + 1, sl_next); } \
    CMASK(C0, C1, t); \
    { float a = MX3(C0[0], C0[1], C1[0]), b = MX3(C0[2], C0[3], C1[1]); a = MX3(a, C1[2], C1[3]); \
      _Pragma("unroll") for (int r = 4; r < 16; r += 4) { a = MX3(a, C0[r], C0[r + 1]); b = MX3(b, C0[r + 2], C0[r + 3]); a = MX3(a, C1[r], C1[r + 1]); b = MX3(b, C1[r + 2], C1[r + 3]); } \
      float rm = __builtin_fmaxf(a, b); { auto rr = __builtin_amdgcn_permlane32_swap(__float_as_uint(rm), __float_as_uint(rm), false, false); rm = __builtin_fmaxf(__uint_as_float(rr[0]), __uint_as_float(rr[1])); } \
      resc = false; \
      if (__builtin_expect(__any(rm > (float)THRL), 0)) { const float dl = __builtin_fmaxf(rm, 0.f); mhat += dl; \
        _Pragma("unroll") for (int r = 0; r < 16; ++r) { C0[r] -= dl; C1[r] -= dl; } \
        _Pragma("unroll") for (int r = 0; r < 16; ++r) negm[r] = -mhat; asm volatile("" : "+v"(negm)); \
        const float f = __builtin_amdgcn_exp2f(-dl); if (hi == 0) wsf[r32] = f; resc = true; } } \
    SBAR(); \
    GAPB(o[0] = __builtin_amdgcn_mfma_f32_32x32x16_bf16(PAF(0), VFR(0), o[0], 0, 0, 0), C0, 0); \
    GAPB(o[1] = __builtin_amdgcn_mfma_f32_32x32x16_bf16(PAF(0), VFR(4), o[1], 0, 0, 0), C0, 4); \
    lacc = __builtin_amdgcn_mfma_f32_16x16x32_bf16(PAF(0), ones, lacc, 0, 0, 0); \
    KRD(GL, 0); GAPB(o[0] = __builtin_amdgcn_mfma_f32_32x32x16_bf16(PAF(1), VFR(1), o[0], 0, 0, 0), C0, 8); \
    KRD(GL, 1); GAPB(o[1] = __builtin_amdgcn_mfma_f32_32x32x16_bf16(PAF(1), VFR(5), o[1], 0, 0, 0), C0, 12); \
    lacc = __builtin_amdgcn_mfma_f32_16x16x32_bf16(PAF(1), ones, lacc, 0, 0, 0); \
    KRD(GL, 2); GAPB(o[0] = __builtin_amdgcn_mfma_f32_32x32x16_bf16(PAF(2), VFR(2), o[0], 0, 0, 0), C1, 0); \
    KRD(GL, 3); GAPB(o[1] = __builtin_amdgcn_mfma_f32_32x32x16_bf16(PAF(2), VFR(6), o[1], 0, 0, 0), C1, 4); \
    lacc = __builtin_amdgcn_mfma_f32_16x16x32_bf16(PAF(2), ones, lacc, 0, 0, 0); \
    GAPB(o[0] = __builtin_amdgcn_mfma_f32_32x32x16_bf16(PAF(3), VFR(3), o[0], 0, 0, 0), C1, 8); \
    GAPB(o[1] = __builtin_amdgcn_mfma_f32_32x32x16_bf16(PAF(3), VFR(7), o[1], 0, 0, 0), C1, 12); \
    lacc = __builtin_amdgcn_mfma_f32_16x16x32_bf16(PAF(3), ones, lacc, 0, 0, 0); \
    } while (0)
#endif
  int t = 1;
  for (; t + 5 < NT; t += 2) {
    STEP(pB0, pB1, pA0, pA1, t, true, true, true);     WAIT_STEADY(); RESC(); ROT();
    STEP(pA0, pA1, pB0, pB1, t + 1, true, true, true); WAIT_STEADY(); RESC(); ROT();
  }
#if PV_F8 && DMA_ROLES
#define ENDW(tt) do { if ((tt) + 3 < NT) { WAIT_BAR(1); } else { WAIT_BAR(0); } } while (0)
#else
#define ENDW(tt) do { if ((tt) + 3 < NT) { WAIT_BAR(2); } else if ((tt) + 2 < NT) { WAIT_BAR(1); } else { WAIT_BAR(0); } } while (0)
#endif
  for (; t + 1 < NT; t += 2) {
    STEP(pB0, pB1, pA0, pA1, t, (t + 3 < NT), (t + 1 < NT), (t + 1 < NT));       ENDW(t);     RESC(); ROT();
    STEP(pA0, pA1, pB0, pB1, t + 1, (t + 4 < NT), (t + 2 < NT), (t + 2 < NT));   ENDW(t + 1); RESC(); ROT();
  }
  STEP(pB0, pB1, pA0, pA1, NT - 1, false, false, false); RESC();
#if PV_F8
  { p8lo = (u32x4){PK4(pB0, 0), PK4(pB0, 4), PK4(pB0, 8), PK4(pB0, 12)}; p8hi = (u32x4){PK4(pB1, 0), PK4(pB1, 4), PK4(pB1, 8), PK4(pB1, 12)};
    SBAR(); const lds_cptr vp_ = vp0 + sl_cur;
    VRD(0); VRD(1); VRD(2); VRD(3); VRD(4); VRD(5); VRD(6); VRD(7);
    PVM(0); PVM(1); lacc = LSUM(); }
#else
  {
    pw0 = (u32x4){PKW(pB0, 0), PKW(pB0, 2), PKW(pB0, 4), PKW(pB0, 6)}; pw1 = (u32x4){PKW(pB0, 8), PKW(pB0, 10), PKW(pB0, 12), PKW(pB0, 14)}; pw2 = (u32x4){PKW(pB1, 0), PKW(pB1, 2), PKW(pB1, 4), PKW(pB1, 6)}; pw3 = (u32x4){PKW(pB1, 8), PKW(pB1, 10), PKW(pB1, 12), PKW(pB1, 14)};
    SBAR(); pv(o, vb0 + sl_cur, PAF(0), PAF(1), PAF(2), PAF(3));
    lacc = __builtin_amdgcn_mfma_f32_16x16x32_bf16(PAF(0), ones, lacc, 0, 0, 0); lacc = __builtin_amdgcn_mfma_f32_16x16x32_bf16(PAF(1), ones, lacc, 0, 0, 0);
    lacc = __builtin_amdgcn_mfma_f32_16x16x32_bf16(PAF(2), ones, lacc, 0, 0, 0); lacc = __builtin_amdgcn_mfma_f32_16x16x32_bf16(PAF(3), ones, lacc, 0, 0, 0); }
#endif
#undef PKW
#undef PAF
#undef VFR
#undef PIN
#undef MX3
#undef GAPA
#undef GAPB
#undef EX
#undef VRD
#undef KRD
#undef STEP
#undef ENDW
  if ((lane & 7) == 0) { const int lr0_ = LROW0();
#pragma unroll
    for (int r = 0; r < 4; ++r) wsf[32 + lr0_ + r] = lacc[r]; }
#undef LROW0
  asm volatile("s_waitcnt lgkmcnt(0)" ::: "memory");
  float rli[16];
#pragma unroll
  for (int r = 0; r < 16; ++r) rli[r] = __builtin_amdgcn_rcpf(wsf[32 + crow(r, hi)]);
  bf16* Ow = Ow0 + (long)(wid * QBLK) * OP;
  { bf16* stg = (bf16*)(shm + LDS_OST) + wid * 2048;
#pragma unroll
    for (int r = 0; r < 16; ++r) { const int orow = crow(r, hi);
#pragma unroll
      for (int d0 = 0; d0 < 2; ++d0) stg[orow * 64 + d0 * 32 + r32] = __float2bfloat16(o[d0][r] * rli[r]); }
    asm volatile("s_waitcnt lgkmcnt(0)" ::: "memory");
#pragma unroll
    for (int i = 0; i < 4; ++i) { const int row = i * 8 + (lane >> 3), ch = lane & 7; const u32x4 v = *(const u32x4*)(stg + row * 64 + ch * 8); *(u32x4*)(Ow + (long)row * OP + ch * 8) = v;
      float q = (bflo(v.x) * bflo(v.x) + bfhi(v.x) * bfhi(v.x)) + (bflo(v.y) * bflo(v.y) + bfhi(v.y) * bfhi(v.y)) + (bflo(v.z) * bflo(v.z) + bfhi(v.z) * bfhi(v.z)) + (bflo(v.w) * bflo(v.w) + bfhi(v.w) * bfhi(v.w));
      q += shx(q, 1, lane); q += shx(q, 2, lane); q += shx(q, 4, lane); if (ch == 0) st0[(long)(wid * QBLK + row) * 80] = q; } }
  asm volatile("s_waitcnt lgkmcnt(0)\n\ts_barrier" ::: "memory");
#undef DMA_K
#undef DMA_V
#undef TROW
#undef CMASK
#undef START
#undef RESC
#undef ROT
}
#undef SBAR
#undef WAIT_BAR
}

#define XB_TMO      128
#define XB_XCNT(j)  (256  + 64 * (j))
#define XB_XSUB(j)  (1280 + 64 * (j))
#define XB_XGEN(j)  (2304 + 64 * (j))
#define XB_TOP      3328
#define XB_TOPGEN   3392
#define XCD_BAR_WORDS 3456
#define XB_SPIN_CAP (1u << 18)
__device__ __forceinline__ unsigned xb_ld(unsigned* p)              { return __hip_atomic_load((GAS unsigned*)p, __ATOMIC_RELAXED, __HIP_MEMORY_SCOPE_AGENT); }
__device__ __forceinline__ unsigned xb_add(unsigned* p, unsigned v) { return __hip_atomic_fetch_add((GAS unsigned*)p, v, __ATOMIC_RELAXED, __HIP_MEMORY_SCOPE_AGENT); }
__device__ __forceinline__ unsigned xb_xcc_id() { return (unsigned)__builtin_amdgcn_s_getreg((3 << 11) | 20) & 0xFu; }
#define XB_SPIN(cond, bar) do { unsigned _sp = 0; while (cond) { __builtin_amdgcn_s_sleep(1); \
    if ((++_sp & 255u) == 0u) { if (xb_ld(&(bar)[XB_TMO])) break; if (_sp > XB_SPIN_CAP) { (void)xb_add(&(bar)[XB_TMO], 1u); break; } } } } while (0)
struct XcdBarrier { unsigned* bar; unsigned x; volatile LAS unsigned* st; };
__device__ __forceinline__ XcdBarrier xcd_barrier_post(unsigned* bar, volatile LAS unsigned* st) {
    XcdBarrier b; b.bar = bar; b.x = xb_xcc_id(); b.st = st;
    if (threadIdx.x == 0) (void)xb_add(&bar[XB_XCNT(b.x)], 1u);
    return b;
}
__device__ __forceinline__ void xcd_barrier_complete(unsigned* bar, unsigned x, unsigned& nloc, unsigned& nx) {
    const unsigned G = gridDim.x * gridDim.y * gridDim.z;
    unsigned sum, cnt, mine, sp = 0u;
    for (;;) {
        sum = 0u; cnt = 0u; mine = 0u;
#pragma nounroll
        for (unsigned j = 0; j < 16; ++j) { const unsigned c = xb_ld(&bar[XB_XCNT(j)]); sum += c; cnt += (c > 0u) ? 1u : 0u; mine = (j == x) ? c : mine; }
        if (sum == G) break;
        __builtin_amdgcn_s_sleep(1);
        if ((++sp & 255u) == 0u) { if (xb_ld(&bar[XB_TMO])) break; if (sp > XB_SPIN_CAP) { (void)xb_add(&bar[XB_TMO], 1u); break; } }
    }
    nloc = mine > 0u ? mine : 1u; nx = cnt > 0u ? cnt : 1u;
}
__device__ __forceinline__ void xcd_barrier(const XcdBarrier& b) {
    asm volatile("s_waitcnt vmcnt(0)" ::: "memory");
    __syncthreads();
    if (threadIdx.x == 0) {
        unsigned* bar = b.bar;
        __builtin_amdgcn_s_waitcnt(0);
        unsigned nloc = b.st[0], nx = b.st[1];
        if (nloc == 0u) { xcd_barrier_complete(bar, b.x, nloc, nx); b.st[0] = nloc; b.st[1] = nx; }
        const unsigned old = xb_add(&bar[XB_XSUB(b.x)], 1u);
        const unsigned gen = old / nloc;
        if (old + 1u == (gen + 1u) * nloc) {
            __builtin_amdgcn_fence(__ATOMIC_RELEASE, "agent");
            asm volatile("s_waitcnt vmcnt(0)" ::: "memory");
            const unsigned og = xb_add(&bar[XB_TOP], 1u);
            const unsigned tg = og / nx;
            if (og + 1u == (tg + 1u) * nx) xb_add(&bar[XB_TOPGEN], 1u);
            else XB_SPIN(xb_ld(&bar[XB_TOPGEN]) == tg, bar);
            __builtin_amdgcn_fence(__ATOMIC_ACQUIRE, "agent");
            xb_add(&bar[XB_XGEN(b.x)], 1u);
            asm volatile("s_waitcnt vmcnt(0)" ::: "memory");
        } else {
            XB_SPIN(xb_ld(&bar[XB_XGEN(b.x)]) == gen, bar);
            __builtin_amdgcn_fence(__ATOMIC_ACQUIRE, "agent");
            asm volatile("s_waitcnt vmcnt(0)" ::: "memory");
        }
    }
    __syncthreads();
}

struct Args {
    const float *x, *c, *ctx, *c_ctx, *w_ada, *b_ada, *g_mix, *g_ffn, *w_in, *g_q, *g_k, *rel_bias, *g_out_a, *g_out_b, *g_out_c, *w_out, *w_router, *w_gate, *w_up, *w_down, *g_final;
    float* out; unsigned char* ws; int ph_lo, ph_hi;
};
constexpr int NWAVES = 8;
constexpr int PH_PER_LAYER = 9;
constexpr int NPHASE = 1 + 2 * PH_PER_LAYER;

__device__ __forceinline__ void tr_item8(const float* W, int N, int k0, int n0, unsigned char* WT, int K, int out_row0, int out_row1  , float scale, LAS float* scr, int lane) {
    f32x4 v[16];
    const int lr = lane >> 4, lc4 = 4 * (lane & 15);
#pragma unroll
    for (int i = 0; i < 16; ++i) v[i] = *(const f32x4*)(W + (size_t)(k0 + 4 * i + lr) * N + n0 + lc4);
#pragma unroll
    for (int i = 0; i < 16; ++i) { LAS float* d = scr + (4 * i + lr) * 65 + lc4;
        d[0] = v[i].x * scale; d[1] = v[i].y * scale; d[2] = v[i].z * scale; d[3] = v[i].w * scale; }
    LDS_WAIT(); asm volatile("" ::: "memory");
    const int c = lane & 7;
#pragma unroll
    for (int j = 0; j < 8; ++j) { const int n = (lane >> 3) + 8 * j; const LAS float* sp = scr + (8 * c) * 65 + n;
        u32x2 o; o.x = pk4_fp8(sp[0 * 65], sp[1 * 65], sp[2 * 65], sp[3 * 65]); o.y = pk4_fp8(sp[4 * 65], sp[5 * 65], sp[6 * 65], sp[7 * 65]);
        *(u32x2*)(WT + (size_t)((j < 4) ? out_row0 + n : out_row1 + n - 32) * K + k0 + 8 * c) = o; }
    LDS_WAIT(); asm volatile("" ::: "memory");
}
__device__ __forceinline__ void tr_item(const float* W, int N, int k0, int n0, bf16_t* WT, int K, int out_row0, int out_row1  , float scale, const float* kscale, LAS float* scr, int lane) {
    f32x4 v[16];
    const int lr = lane >> 4, lc4 = 4 * (lane & 15);
#pragma unroll
    for (int i = 0; i < 16; ++i) v[i] = *(const f32x4*)(W + (size_t)(k0 + 4 * i + lr) * N + n0 + lc4);
#pragma unroll
    for (int i = 0; i < 16; ++i) { float sc = scale; if (kscale) sc *= kscale[k0 + 4 * i + lr]; LAS float* d = scr + (4 * i + lr) * 65 + lc4;
        d[0] = v[i].x * sc; d[1] = v[i].y * sc; d[2] = v[i].z * sc; d[3] = v[i].w * sc; }
    LDS_WAIT(); asm volatile("" ::: "memory");
    const int c = lane & 7;
#pragma unroll
    for (int j = 0; j < 8; ++j) { const int n = (lane >> 3) + 8 * j; const LAS float* sp = scr + (8 * c) * 65 + n;
        u32x4 o; o.x = pg8::cvt_pk_bf16(sp[0 * 65], sp[1 * 65]); o.y = pg8::cvt_pk_bf16(sp[2 * 65], sp[3 * 65]); o.z = pg8::cvt_pk_bf16(sp[4 * 65], sp[5 * 65]); o.w = pg8::cvt_pk_bf16(sp[6 * 65], sp[7 * 65]);
        *(u32x4*)(WT + (size_t)((j < 4) ? out_row0 + n : out_row1 + n - 32) * K + k0 + 8 * c) = o; }
    LDS_WAIT(); asm volatile("" ::: "memory");
}

__device__ __forceinline__ void norm_mod_row(f32x4 (&v)[4], const float* g, const float* shift, const float* scale, int lane) {
    float s = 0.f;
#pragma unroll
    for (int j = 0; j < 4; ++j) s += (v[j].x * v[j].x + v[j].y * v[j].y) + (v[j].z * v[j].z + v[j].w * v[j].w);
    const float r = 1.0f / sqrtf(wave_sum(s, lane) * (1.f / DM) + EPS);
#pragma unroll
    for (int j = 0; j < 4; ++j) { const int c = 4 * lane + 256 * j; const f32x4 gv = *(const f32x4*)(g + c);
        f32x4 y = v[j] * r * gv;
        if (shift) { const f32x4 sh = *(const f32x4*)(shift + c), sc = *(const f32x4*)(scale + c); y = y * (sc + 1.0f) + sh; }
        v[j] = y; }
}
__device__ __forceinline__ void store_row_fp8(unsigned char* orow, const f32x4 (&v)[4], int lane) {
#pragma unroll
    for (int j = 0; j < 4; ++j) *(unsigned*)(orow + 4 * lane + 256 * j) = pk4_fp8(v[j].x, v[j].y, v[j].z, v[j].w);
}
__device__ __forceinline__ void store_row_bf16(bf16_t* orow, const f32x4 (&v)[4], int lane) {
#pragma unroll
    for (int j = 0; j < 4; ++j) { u32x2 w; w.x = pk2(v[j].x, v[j].y); w.y = pk2(v[j].z, v[j].w); *(u32x2*)(orow + 4 * lane + 256 * j) = w; }
}

constexpr int FT_M1 = 69632, FT_W3 = FT_M1 + 128 * 272, FT_P = 136;
__device__ __forceinline__ void fourier_tables_to_lds(LAS unsigned char* lds, const bf16_t* M1, const bf16_t* W3) {
    const int tid = tid_fresh();
    for (int i = tid; i < (128 + 64) * 16; i += 512) { const int row = i >> 4, c = i & 15; const u32x4 v = *(const u32x4*)((row < 128 ? M1 + row * 128 : W3 + (row - 128) * 128) + 8 * c);
        *(LAS u32x4*)(lds + FT_M1 + row * 272 + 16 * c) = v; }
    __syncthreads();
}
__device__ __forceinline__ void fourier_unit(LAS unsigned char* lds, const bf16_t* QKV, bf16_t* OCAT, const float* TW, float* ST, int b, int g, int lc) {
    const int tid = tid_fresh(), lane = tid & 63, wid = __builtin_amdgcn_readfirstlane(tid >> 6), r32 = lane & 31, h = lane >> 5;
    LAS bf16_t* XT = (LAS bf16_t*)lds;
    constexpr int XP = 136;
#pragma unroll 4
    for (int it = 0; it < 16; ++it) { const int combo = it * 8 + wid, ri = combo >> 6, n2 = combo & 63, n1 = lane, token = 64 * n1 + n2;
        const u32x2 v = *(const u32x2*)(QKV + O_VRI + (size_t)(b * TT + token) * 512 + ri * 256 + g * 64 + 4 * lc);
        const int col = ri * 64 + n1;
        XT[(0 * 64 + n2) * XP + col] = (bf16_t)(v.x & 0xffffu); XT[(1 * 64 + n2) * XP + col] = (bf16_t)(v.x >> 16);
        XT[(2 * 64 + n2) * XP + col] = (bf16_t)(v.y & 0xffffu); XT[(3 * 64 + n2) * XP + col] = (bf16_t)(v.y >> 16); }
    __syncthreads();
    f32x16 acc[4];
#pragma unroll
    for (int ct = 0; ct < 4; ++ct) acc[ct] = f32x16{};
#pragma unroll
    for (int s = 0; s < 8; ++s) {
        const bf16x8 a = *(const LAS bf16x8*)(XT + (32 * wid + r32) * XP + 16 * s + 8 * h);
#pragma unroll
        for (int ct = 0; ct < 4; ++ct) { const bf16x8 bb = *(const LAS bf16x8*)(lds + FT_M1 + ((32 * ct + r32) * FT_P + 16 * s + 8 * h) * 2);
            acc[ct] = __builtin_amdgcn_mfma_f32_32x32x16_bf16(a, bb, acc[ct], 0, 0, 0); } }
    __syncthreads();
    {
        const int l = wid >> 1;
#pragma unroll
        for (int q = 0; q < 2; ++q) { const int k1 = 32 * q + r32;
#pragma unroll
            for (int rg = 0; rg < 4; ++rg) { const int n2_0 = 32 * (wid & 1) + 8 * rg + 4 * h;
                const f32x4 t0 = *(const f32x4*)(TW + ((size_t)k1 * 64 + n2_0) * 2), t1 = *(const f32x4*)(TW + ((size_t)k1 * 64 + n2_0) * 2 + 4);
                const float cs[4] = {t0.x, t0.z, t1.x, t1.z}, sn[4] = {t0.y, t0.w, t1.y, t1.w};
                float pr[4], pi[4];
#pragma unroll
                for (int j = 0; j < 4; ++j) { const float gr = acc[q][4 * rg + j], gi = acc[q + 2][4 * rg + j]; pr[j] = gr * cs[j] + gi * sn[j]; pi[j] = gi * cs[j] - gr * sn[j]; }
                u32x2 wr_, wi_; wr_.x = pk2(pr[0], pr[1]); wr_.y = pk2(pr[2], pr[3]); wi_.x = pk2(pi[0], pi[1]); wi_.y = pk2(pi[2], pi[3]);
                const int sw = (k1 & 7) << 3;
                *(LAS u32x2*)(XT + (4 * k1 + l) * XP + ((n2_0 & ~7) ^ sw) + (n2_0 & 7)) = wr_; *(LAS u32x2*)(XT + (4 * k1 + l) * XP + (((64 + n2_0) & ~7) ^ sw) + (n2_0 & 7)) = wi_; } }
    }
    __syncthreads();
    f32x16 o[2]; o[0] = f32x16{}; o[1] = f32x16{};
    const int swr = (((32 * wid + r32) >> 2) & 7) << 3;
#pragma unroll
    for (int s = 0; s < 8; ++s) {
        const bf16x8 a = *(const LAS bf16x8*)(XT + (32 * wid + r32) * XP + ((16 * s + 8 * h) ^ swr));
#pragma unroll
        for (int ct = 0; ct < 2; ++ct) { const bf16x8 bb = *(const LAS bf16x8*)(lds + FT_W3 + ((32 * ct + r32) * FT_P + 16 * s + 8 * h) * 2);
            o[ct] = __builtin_amdgcn_mfma_f32_32x32x16_bf16(a, bb, o[ct], 0, 0, 0); } }
#pragma unroll
    for (int ct = 0; ct < 2; ++ct) { const int k2 = 32 * ct + r32;
#pragma unroll
        for (int rg = 0; rg < 4; ++rg) { const int k1 = 8 * wid + 2 * rg + h, token = k1 + 64 * k2;
            u32x2 w; w.x = pk2(o[ct][4 * rg + 0], o[ct][4 * rg + 1]); w.y = pk2(o[ct][4 * rg + 2], o[ct][4 * rg + 3]);
            *(u32x2*)(OCAT + (size_t)(b * TT + token) * DM + 512 + g * 64 + 4 * lc) = w;
            ST[(size_t)(b * TT + token) * 80 + 12 + g * 16 + lc] = (bflo(w.x) * bflo(w.x) + bfhi(w.x) * bfhi(w.x)) + (bflo(w.y) * bflo(w.y) + bfhi(w.y) * bfhi(w.y)); } }
    __syncthreads();
}

__device__ __forceinline__ void fourier_ctx_unit(LAS unsigned char* lds, const bf16_t* QKV, bf16_t* OCAT, const bf16_t* CSC, float* ST, int b, int g) {
    const int tid = tid_fresh(), lane = tid & 63, wid = __builtin_amdgcn_readfirstlane(tid >> 6), r32 = lane & 31, h = lane >> 5;
    LAS bf16_t* VT = (LAS bf16_t*)lds; constexpr int VP = 520;
#pragma unroll
    for (int it = 0; it < 8; ++it) { const int p = it * 512 + tid, n = p & 255, c8 = (p >> 8) & 7, ri = p >> 11;
        const u32x4 v = *(const u32x4*)(QKV + O_VRI + (size_t)(b * TT + SEQ + n) * 512 + ri * 256 + g * 64 + 8 * c8);
        LAS bf16_t* d = VT + (8 * c8) * VP + ri * 256 + n;
        d[0 * VP] = (bf16_t)(v.x & 0xffffu); d[1 * VP] = (bf16_t)(v.x >> 16); d[2 * VP] = (bf16_t)(v.y & 0xffffu); d[3 * VP] = (bf16_t)(v.y >> 16);
        d[4 * VP] = (bf16_t)(v.z & 0xffffu); d[5 * VP] = (bf16_t)(v.z >> 16); d[6 * VP] = (bf16_t)(v.w & 0xffffu); d[7 * VP] = (bf16_t)(v.w >> 16); }
    __syncthreads();
    f32x16 acc[2]; acc[0] = f32x16{}; acc[1] = f32x16{};
    const bf16_t* bp = CSC + (size_t)(32 * wid + r32) * 512 + 8 * h;
#pragma unroll 8
    for (int s = 0; s < 32; ++s) { const bf16x8 bb = *(const bf16x8*)(bp + 16 * s);
#pragma unroll
        for (int rt = 0; rt < 2; ++rt) { const bf16x8 a = *(const LAS bf16x8*)(VT + (32 * rt + r32) * VP + 16 * s + 8 * h); acc[rt] = __builtin_amdgcn_mfma_f32_32x32x16_bf16(a, bb, acc[rt], 0, 0, 0); } }
    const int k = 32 * wid + r32;
#pragma unroll
    for (int rt = 0; rt < 2; ++rt)
#pragma unroll
        for (int rg = 0; rg < 4; ++rg) { u32x2 w; w.x = pk2(acc[rt][4 * rg + 0], acc[rt][4 * rg + 1]); w.y = pk2(acc[rt][4 * rg + 2], acc[rt][4 * rg + 3]);
            *(u32x2*)(OCAT + (size_t)(b * TT + SEQ + k) * DM + 512 + g * 64 + 32 * rt + 8 * rg + 4 * h) = w;
            ST[(size_t)(b * TT + SEQ + k) * 80 + 12 + g * 16 + rt * 8 + rg * 2 + h] = (bflo(w.x) * bflo(w.x) + bfhi(w.x) * bfhi(w.x)) + (bflo(w.y) * bflo(w.y) + bfhi(w.y) * bfhi(w.y)); }
    __syncthreads();
}

typedef const __attribute__((address_space(4))) Args* KArgs;
#define PHASE_ENV \
    KArgs ka = (KArgs)__builtin_amdgcn_kernarg_segment_ptr(); asm volatile("" : "+s"(ka)); \
    int G = G0, bx = bx0, vcu = vcu0; asm volatile("" : "+s"(G), "+s"(bx), "+s"(vcu));     \
    const int tid = tid_fresh(), lane = tid & 63, wave = __builtin_amdgcn_readfirstlane(tid >> 6), gw = vcu * NWAVES + wave, NGW = G * NWAVES; (void)lane; (void)gw; (void)NGW; (void)bx; \
    unsigned char* ws = ka->ws; (void)ws; \
    float* MODP = (float*)(ws + WS_MODP); float* MOD = (float*)(ws + WS_MOD); (void)MODP; (void)MOD; \
    float* ROPE = (float*)(ws + WS_TAB + TAB_ROPE); bf16_t* M1 = (bf16_t*)(ws + WS_TAB + TAB_M1); bf16_t* W3 = (bf16_t*)(ws + WS_TAB + TAB_W3); (void)ROPE; (void)M1; (void)W3; \
    float* TW = (float*)(ws + WS_TAB + TAB_TW); float* TWC = (float*)(ws + WS_TAB + TAB_TWC); bf16_t* CSC = (bf16_t*)(ws + WS_TAB + TAB_CSC); (void)TW; (void)TWC; (void)CSC; \
    float* AFF = (float*)(ws + WS_AFF); int* SEL = (int*)(ws + WS_SEL); int* IDX = (int*)(ws + WS_IDX); (void)AFF; (void)SEL; (void)IDX; \
    unsigned char* WIN = ws + WS_WIN; bf16_t* WOUT = (bf16_t*)(ws + WS_WOUT); unsigned char* WGU = ws + WS_WGU; unsigned char* WD = ws + WS_WD; (void)WIN; (void)WOUT; (void)WGU; (void)WD; \
    bf16_t* X = (bf16_t*)(ws + WS_X); bf16_t* QKV = (bf16_t*)(ws + WS_QKV); bf16_t* OCAT = (bf16_t*)(ws + WS_OCAT); unsigned char* H = ws + WS_H; (void)X; (void)QKV; (void)OCAT; (void)H; \
    unsigned char* ACT = ws + WS_ACT; unsigned char* H2 = ws + WS_H2; bf16_t* YS = (bf16_t*)(ws + WS_YS); float* ST = (float*)(ws + WS_ST); (void)ACT; (void)H2; (void)YS; (void)ST;
#define PHASE_ENV_L \
    PHASE_ENV \
    const float* mod = MOD + (size_t)l * 9 * 6144; (void)mod; \
    const unsigned char* win = WIN + (size_t)l * NQ * DM * (INPROJ_F8 ? 1 : 2); const bf16_t* wout = WOUT + (size_t)l * DM * DM; (void)win; (void)wout; \
    const unsigned char* wgu = WGU + (size_t)l * NE * 4096 * DM; const unsigned char* wd = WD + (size_t)l * NE * DM * FF; (void)wgu; (void)wd;
constexpr int TAIL_IN = 2, TAIL_OUT = 4, TAIL_G2 = 3;
constexpr int TAIL_BLKS = 192 * TAIL_IN + 224 * TAIL_OUT + 192 * TAIL_G2;
__device__ __forceinline__ void cvt_expert_blocks(LAS unsigned char* lds, KArgs ka, unsigned char* WGU, unsigned char* WD, int wave, int lane, int base, int first, int step, int limit, int gap_at, int gap_len) {
    constexpr int XS = 132, XB = 256 * XS;
#define XBLK(j_) (first + (j_) * step)
#define XDEC(blk_, WT_, K_, kb_, nb_, wh_, sp_, N_) do { const int id_ = base + (blk_) + (((blk_) >= gap_at) ? gap_len : 0); const int le_ = id_ / 192, r_ = id_ % 192, q_ = r_ % 64; wh_ = r_ / 64; const float* src_; \
        if (wh_ < 2) { src_ = (wh_ == 0 ? ka->w_gate : ka->w_up) + (size_t)le_ * DM * FF; N_ = FF; kb_ = q_ / 8; nb_ = q_ % 8; WT_ = WGU + (size_t)le_ * 4096 * DM; K_ = DM; } \
        else { src_ = ka->w_down + (size_t)le_ * FF * DM; N_ = DM; kb_ = q_ / 4; nb_ = q_ % 4; WT_ = WD + (size_t)le_ * DM * FF; K_ = FF; } \
        sp_ = src_ + (size_t)(kb_ * 128 + wave * 16) * N_ + nb_ * 256 + 4 * lane; } while (0)
#define XLOAD(v_, sp_, N_) do { _Pragma("unroll") for (int i = 0; i < 16; ++i) v_[i] = *(const f32x4*)(sp_ + (size_t)i * N_); } while (0)
#define XOUT(bufi_, WT_, K_, kb_, nb_, wh_) do { const LAS unsigned char* bp_ = lds + (bufi_) * XB; \
        _Pragma("unroll") for (int jj = 0; jj < 4; ++jj) { const int row = 32 * wave + 8 * jj + (lane >> 3), c = lane & 7; const LAS unsigned* rp = (const LAS unsigned*)(bp_ + row * XS + 16 * c); \
            u32x4 o; o.x = rp[0]; o.y = rp[1]; o.z = rp[2]; o.w = rp[3]; \
            const int n = nb_ * 256 + row; const int orow = (wh_ < 2) ? 256 * (n >> 7) + (n & 127) + wh_ * 128 : n; \
            *(u32x4*)(WT_ + (size_t)orow * K_ + kb_ * 128 + 16 * c) = o; } } while (0)
#define XCVT(bufi_, v_) do { LAS unsigned char* bq_ = lds + (bufi_) * XB + (4 * lane) * XS + wave * 16; \
        _Pragma("unroll") for (int q4 = 0; q4 < 4; ++q4) _Pragma("unroll") for (int jn = 0; jn < 4; ++jn) \
            *(LAS unsigned*)(bq_ + jn * XS + 4 * q4) = pk4_fp8(v_[4 * q4][jn] * WSC8, v_[4 * q4 + 1][jn] * WSC8, v_[4 * q4 + 2][jn] * WSC8, v_[4 * q4 + 3][jn] * WSC8); } while (0)
    f32x4 va[16], vb[16];
    unsigned char* aWT = nullptr; int aK = 0, akb = 0, anb = 0, awh = 0; unsigned char* bWT = nullptr; int bK = 0, bkb = 0, bnb = 0, bwh = 0;
    unsigned char* pWT = nullptr; int pK = 0, pkb = 0, pnb = 0, pwh = 0; bool have_prev = false;
    { const int blk = XBLK(0); if (blk < limit) { const float* sp; int N; XDEC(blk, aWT, aK, akb, anb, awh, sp, N); XLOAD(va, sp, N); } }
    for (int j = 0;; j += 2) {
        { const int blk = XBLK(j); const bool valid = blk < limit; const int blk1 = XBLK(j + 1);
          if (valid && blk1 < limit) { const float* sp; int N; XDEC(blk1, bWT, bK, bkb, bnb, bwh, sp, N); XLOAD(vb, sp, N); }
          if (have_prev) XOUT(1, pWT, pK, pkb, pnb, pwh);
          if (!valid) break;
          XCVT(0, va); __syncthreads();
          have_prev = true; pWT = aWT; pK = aK; pkb = akb; pnb = anb; pwh = awh; }
        { const int blk = XBLK(j + 1); const bool valid = blk < limit; const int blk2 = XBLK(j + 2);
          if (valid && blk2 < limit) { const float* sp; int N; XDEC(blk2, aWT, aK, akb, anb, awh, sp, N); XLOAD(va, sp, N); }
          XOUT(0, pWT, pK, pkb, pnb, pwh);
          if (!valid) break;
          XCVT(1, vb); __syncthreads();
          pWT = bWT; pK = bK; pkb = bkb; pnb = bnb; pwh = bwh; } }
    __syncthreads();
#undef XBLK
#undef XDEC
#undef XLOAD
#undef XOUT
#undef XCVT
}
__global__ void __launch_bounds__(NWAVES * 64, 2) fwd_kernel(Args args) {
    extern __shared__ __attribute__((aligned(16))) unsigned char lds_raw[];
    LAS unsigned char* lds = (LAS unsigned char*)lds_raw;
    volatile LAS unsigned* MISC = (volatile LAS unsigned*)(lds + MISC_OFF);
    const int G0 = gridDim.x, bx0 = blockIdx.x;
    const int vcu0 = (G0 % 8 == 0) ? (bx0 % 8) * (G0 / 8) + bx0 / 8 : bx0;
    unsigned* ctl = (unsigned*)(args.ws + WS_CTL);
    for (int u = threadIdx.x; u < (LDS_BYTES - LDSCTL_OFF) / 4; u += NWAVES * 64) ((LAS unsigned*)(lds + LDSCTL_OFF))[u] = 0u;
    __syncthreads();
    XcdBarrier bar; bar.bar = ctl + CW_BAR; bar.x = 0; bar.st = nullptr;
    if (!MK_PER_PHASE) bar = xcd_barrier_post(ctl + CW_BAR, MISC + 8);
    const int lo = args.ph_lo, hi = args.ph_hi;
#define IN(k) (lo <= (k) && (k) < hi)
#define SEAM(k) do { if (IN(k) && IN((k) + 1)) { XcdBarrier b_ = bar; asm volatile("" : "+s"(b_.bar));     \
        xcd_barrier(b_); } } while (0)


    for (int rep_ = 0; rep_ < REPS(1); ++rep_)
    if (IN(0)) { PHASE_ENV
        __syncthreads();
        if (vcu >= G - 24) {
            LAS float* SL = (LAS float*)lds;
            for (int i = tid; i < 9 * DM; i += 512) { const int r = i >> 10, k = i & 1023; const float cv = (r < 8) ? ka->c[r * DM + k] : ka->c_ctx[k]; SL[i] = cv / (1.0f + expf(-cv)); }
            __syncthreads();
            const int it = (vcu - (G - 24)) * NWAVES + wave;
            const int l = it / 96, col = (it % 96) * 64 + lane; float acc[9];
#pragma unroll
            for (int r = 0; r < 9; ++r) acc[r] = 0.f;
            const float* wp = ka->w_ada + (size_t)l * DM * 6144 + col;
            for (int k = 0; k < DM; k += 16) { float w[16];
#pragma unroll
                for (int q = 0; q < 16; ++q) w[q] = wp[(size_t)(k + q) * 6144];
#pragma unroll
                for (int r = 0; r < 9; ++r)
#pragma unroll
                    for (int q4 = 0; q4 < 4; ++q4) { const f32x4 sv = *(const LAS f32x4*)(SL + r * DM + k + 4 * q4); acc[r] += sv.x * w[4 * q4] + sv.y * w[4 * q4 + 1] + sv.z * w[4 * q4 + 2] + sv.w * w[4 * q4 + 3]; } }
            const float bias = ka->b_ada[l * 6144 + col];
#pragma unroll
            for (int r = 0; r < 9; ++r) MOD[((size_t)l * 9 + r) * 6144 + col] = acc[r] + bias;
            __syncthreads();
        }
        { const int gt = vcu * 512 + tid;
          if (gt < 1024) { const int pos = gt >> 4, f = gt & 15; const float inv = powf(10000.0f, -(float)f / 16.0f); const float ang = (float)pos * inv; ROPE[2 * gt] = cosf(ang); ROPE[2 * gt + 1] = sinf(ang); }
          if (gt >= 1024 && gt < 1024 + 128 * 128) { const int i = gt - 1024, row = i >> 7, colk = i & 127; const int ro = row >> 6, k1 = row & 63, ri = colk >> 6, n1 = colk & 63;
              const float ang = 6.283185307179586f * (float)((k1 * n1) & 63) / 64.0f; const float cs = cosf(ang), sn = sinf(ang);
              const float v = (ro == 0) ? (ri == 0 ? cs : sn) : (ri == 0 ? -sn : cs); M1[i] = (bf16_t)f2bf(v); }
          if (gt >= 32768 && gt < 32768 + 64 * 128) { const int i = gt - 32768, k2 = i >> 7, colk = i & 127, ri = colk >> 6, n2 = colk & 63;
              const float ang = 6.283185307179586f * (float)((k2 * n2) & 63) / 64.0f; const float v = (ri == 0 ? cosf(ang) : sinf(ang)) * (1.0f / 512.0f); W3[i] = (bf16_t)f2bf(v); }
          if (gt >= 65536 && gt < 65536 + 4096) { const int i = gt - 65536, k1 = i >> 6, n2 = i & 63; const float ang = 6.283185307179586f * (float)(k1 * n2) / 4096.0f; TW[2 * i] = cosf(ang); TW[2 * i + 1] = sinf(ang); }
          for (int i = gt; i < 256 * 512; i += G * 512) { const int k = i >> 9, kk = i & 511, ri = kk >> 8, n = kk & 255; const float ang = 6.283185307179586f * (float)((k * n) & 255) / 256.0f;
              CSC[i] = (bf16_t)f2bf((ri == 0 ? cosf(ang) : sinf(ang)) * (1.0f / 128.0f)); }
          if (gt >= 80000 && gt < 80000 + 256) { const int j = gt - 80000; const float ang = 6.283185307179586f * (float)j / 256.0f; TWC[2 * j] = cosf(ang); TWC[2 * j + 1] = sinf(ang); } }
        for (int it = gw; it < 2 * 4 * DM; it += NGW) { const int k = it & 1023, g = (it >> 10) & 3, l = it >> 12;
            const float wv = ka->w_in[((size_t)l * DM + k) * 1792 + 768 + g * 64 + lane];
            float ar = 0.f, ai = 0.f;
            for (int c = 0; c < 64; ++c) { const float wc_ = __builtin_bit_cast(float, __builtin_amdgcn_readlane(__builtin_bit_cast(int, wv), c)); const float ang = 6.283185307179586f * (float)((lane * c) & 63) / 64.0f; ar += wc_ * __cosf(ang); ai -= wc_ * __sinf(ang); }
#if INPROJ_F8
            unsigned char* wt = WIN + (size_t)l * NQ * DM; const unsigned pq = pk4_fp8(ar * WSC8, ai * WSC8, 0.f, 0.f);
            wt[(size_t)(C_VR + g * 64 + lane) * DM + k] = (unsigned char)(pq & 0xffu); wt[(size_t)(C_VI + g * 64 + lane) * DM + k] = (unsigned char)((pq >> 8) & 0xffu); }
#else
            bf16_t* wt = (bf16_t*)WIN + (size_t)l * NQ * DM;
            wt[(size_t)(C_VR + g * 64 + lane) * DM + k] = (bf16_t)f2bf(ar); wt[(size_t)(C_VI + g * 64 + lane) * DM + k] = (bf16_t)f2bf(ai); }
#endif
        { LAS float* scr = (LAS float*)(lds + wave * 16896);
          constexpr int I_IN = 16 * 24, I_OUT = 16 * 16, I_L = I_IN + I_OUT;
          for (int it = gw; it < 2 * I_L; it += NGW) {
            const int l = it / I_L; int r = it % I_L;
            if (r < I_IN) { const int kb = r / 24; int nb = r % 24; if (nb >= 12) nb += 4;
                const int n0 = 64 * nb; const float sc = (n0 >= 1024 && n0 < 1280) ? C2 : 1.0f;
                int orow, orow1;
                if (n0 < 512) { const int hq = n0 >> 6; orow = (hq >> 2) * 256 + 32 * (hq & 3); orow1 = orow + 128; }
                else if (n0 < 768) { const int slot = (n0 - 512) >> 6; orow = 512 + 32 * slot; orow1 = orow + 128; }
                else { orow = n0 + 256; orow1 = orow + 32; }
#if INPROJ_F8
                tr_item8(ka->w_in + (size_t)l * DM * 1792, 1792, 64 * kb, n0, WIN + (size_t)l * NQ * DM, DM, orow, orow1, sc * WSC8, scr, lane); continue; }
#else
                tr_item(ka->w_in + (size_t)l * DM * 1792, 1792, 64 * kb, n0, (bf16_t*)WIN + (size_t)l * NQ * DM, DM, orow, orow1, sc, nullptr, scr, lane); continue; }
#endif
            r -= I_IN;
            { const int kb = r / 16, nb = r % 16; const int k0 = 64 * kb;
                const float* ks = (k0 < 512) ? ka->g_out_a + l * 512 : (k0 < 768) ? ka->g_out_b + l * 256 - 512 : ka->g_out_c + l * 256 - 768;
                tr_item(ka->w_out + (size_t)l * DM * DM, DM, k0, 64 * nb, WOUT + (size_t)l * DM * DM, DM, 64 * nb, 64 * nb + 32, 1.0f, ks, scr, lane); } } }
        __syncthreads();
        { const bool is_ada = vcu >= G - 24; const int n_oth = G - 24; constexpr int NV = 6144 - TAIL_BLKS; const int lim_oth = NV - 24 * 6;
          if (is_ada) cvt_expert_blocks(lds, ka, WGU, WD, wave, lane, 0, lim_oth + (vcu - n_oth), 24, NV, 3072, TAIL_BLKS);
          else cvt_expert_blocks(lds, ka, WGU, WD, wave, lane, 0, vcu, n_oth, lim_oth, 3072, TAIL_BLKS); }
    }
    SEAM(0);
    const int nlayers = (DBG_STOP >= 3) ? 2 : 1;
    for (int l = 0; l < nlayers; ++l) {
        const int P = 1 + l * PH_PER_LAYER;
        for (int rep_ = 0; rep_ < REPS(7); ++rep_)
        if (IN(P + 0) && l == 0) { PHASE_ENV_L
            for (int m = gw; m < MROWS; m += NGW) { const int b = m / TT, t = m % TT; const bool isctx = t >= SEQ;
                const float* src = isctx ? ka->ctx + ((size_t)b * CTX + (t - SEQ)) * DM : ka->x + ((size_t)b * SEQ + t) * DM;
                f32x4 v[4];
#pragma unroll
                for (int j = 0; j < 4; ++j) v[j] = *(const f32x4*)(src + 4 * lane + 256 * j);
                store_row_bf16(X + (size_t)m * DM, v, lane);
                const float* mr = mod + (size_t)(isctx ? 8 : b) * 6144;
                norm_mod_row(v, ka->g_mix + l * DM, mr, mr + 1024, lane);
                if (INPROJ_F8) store_row_fp8(H + (size_t)m * DM, v, lane); else store_row_bf16((bf16_t*)H + (size_t)m * DM, v, lane); }
        }
        SEAM(P + 0);
        for (int rep_ = 0; rep_ < REPS(2); ++rep_)
        if (IN(P + 1)) { PHASE_ENV_L
            pg8::Gemm g{(const bf16_t*)H, (const bf16_t*)win, INPROJ_F8 ? DM / 2 : DM}; pg8::GridOrder S; S.init(MROWS / 256, NQ / 256, G, bx, 0);
            pg8::EpiInProj E{QKV, ka->g_q + l * 64, ka->g_k + l * 64, ROPE, INPROJ_F8 ? 1.0f / WSC8 : 1.0f};
            pg8::gemm_phase<pg8::EpiInProj, pg8::GridOrder, true, false, false, (INPROJ_F8 != 0)>(lds, g, S, E);
            if (l == 0 && bx >= 64) { __syncthreads(); cvt_expert_blocks(lds, ka, WGU, WD, wave, lane, 3072, bx - 64, 192, 192 * TAIL_IN, 1 << 30, 0); }
        }
        SEAM(P + 1);
        for (int rep_ = 0; rep_ < REPS(3); ++rep_)
        if (IN(P + 2)) { PHASE_ENV_L
            const attn::bf16* QKVb = (const attn::bf16*)QKV; attn::bf16* OC = (attn::bf16*)OCAT;
#if ATT_F8
#define QKP(off_, idx_) ((const attn::bf16*)((const unsigned char*)(QKVb + (off_)) + (idx_)))
#else
#define QKP(off_, idx_) (QKVb + (off_) + (idx_))
#endif
#if PV_F8
#define VP_(off_, idx_) QKP(off_, idx_)
#else
#define VP_(off_, idx_) (QKVb + (off_) + (idx_))
#endif
            if (DBG_GROUPS & 1) {
            for (int i = 0; i < 4 * REPS(10); ++i) { const int u = (i & 3) * 256 + vcu, grp = u >> 6, b = grp >> 1, kvh = grp & 1, w = u & 63, h = kvh * 4 + (w >> 4), qb = w & 15;
                const size_t qrow = (size_t)b * TT + 256 * qb;
                attn::attn_unit<8, false, 512, 128>(QKP(O_QA, qrow * 512 + h * 64), QKP(O_KA, kvh * 64), VP_(O_VA, kvh * 64), OC + qrow * DM + h * 64, (char*)lds_raw,
                                          68, 68, b * TT, 0, 68, 0, 0, 0, ST + qrow * 80 + h); }
            }
            if (DBG_GROUPS & 4) {
            for (int i = 0; i < 2 * REPS(9); ++i) { const int u = (i & 1) * 256 + vcu, b = u >> 6, w = u & 63, h = w >> 4, qb = w & 15;
                { LAS float* rbt = (LAS float*)(lds + attn::LDS_RB);
                  for (int i2 = tid; i2 < 15 * 128; i2 += 512) { const int dr = i2 >> 7, ii = (i2 & 127) - 48; rbt[i2] = (ii >= 0 && ii < 31) ? ka->rel_bias[(((size_t)l * 4 + h) * 15 + dr) * 31 + ii] * LOG2E : 0.f; }
                  __syncthreads(); }
                const int r0 = 4 * qb; int kr_lo = r0 - 4; kr_lo = kr_lo < 0 ? 0 : (kr_lo > 56 ? 56 : kr_lo); int kr_hi = r0 + 3 - 4; kr_hi = kr_hi < 0 ? 0 : (kr_hi > 56 ? 56 : kr_hi); kr_hi += 7;
                const int n_win = kr_hi - kr_lo + 1; const int nvalid = 4 + n_win; const int NT = (nvalid + 1) & ~1;
                const size_t qrow = (size_t)b * TT + 256 * qb;
                attn::attn_unit<8, true, 256, 256>(QKP(O_QN, qrow * 256 + h * 64), QKP(O_KN, h * 64), VP_(O_VN, h * 64), OC + qrow * DM + 768 + h * 64, (char*)lds_raw,
                                         NT, 4, b * TT + SEQ, b * TT + 64 * kr_lo, nvalid, r0, kr_lo, n_win, ST + qrow * 80 + 8 + h); }
            }
            if (DBG_GROUPS & 2) {
            fourier_tables_to_lds(lds, M1, W3);
            for (int i = 0; i < 2 * REPS(8); ++i) { const int u = (i & 1) * 256 + vcu; fourier_unit(lds, QKV, OCAT, TW, ST, u >> 6, (u >> 4) & 3, u & 15); }
            }
            if (l == 0) {
                if (vcu < 64) { const int b = vcu >> 3, h = vcu & 7, kvh = h >> 2; const size_t qrow = (size_t)b * TT + SEQ;
                    attn::attn_unit<8, false, 512, 128>(QKP(O_QA, qrow * 512 + h * 64), QKP(O_KA, kvh * 64), VP_(O_VA, kvh * 64), OC + qrow * DM + h * 64, (char*)lds_raw,
                                              4, 4, b * TT + SEQ, 0, 4, 0, 0, 0, ST + qrow * 80 + h); }
                else if (vcu < 96) { const int b = (vcu - 64) >> 2, h = (vcu - 64) & 3; const size_t qrow = (size_t)b * TT + SEQ;
                    attn::attn_unit<8, false, 256, 256>(QKP(O_QN, qrow * 256 + h * 64), QKP(O_KN, h * 64), VP_(O_VN, h * 64), OC + qrow * DM + 768 + h * 64, (char*)lds_raw,
                                              4, 4, b * TT + SEQ, 0, 4, 0, 0, 0, ST + qrow * 80 + 8 + h); }
                else if (vcu < 128) { const int u = vcu - 96; fourier_ctx_unit(lds, QKV, OCAT, CSC, ST, u >> 2, u & 3); }
            }
        }
        SEAM(P + 2);
        for (int rep_ = 0; rep_ < ((l == 0) ? REPS(7) : 1); ++rep_)
        if (IN(P + 3)) { PHASE_ENV_L
            pg8::Gemm g{OCAT, wout, DM}; pg8::GridOrder S; S.init(l == 0 ? MROWS / 256 : 128, DM / 256, G, bx, l == 1);
            for (int ui = 0; ui < 3; ++ui) { pg8::Unit u; if (!S.next(ui, u)) break;
                LAS float* rs = (LAS float*)(lds + RS_OFF) + ui * 768;
                if (tid < 256) { const f32x4* p = (const f32x4*)(ST + ((size_t)u.pm * 256 + tid) * 80);
                    f32x4 q[19];
#pragma unroll
                    for (int i = 0; i < 19; ++i) q[i] = p[i];
                    const f32x4 a4 = q[0] + q[1]; f32x4 b4 = q[3];
#pragma unroll
                    for (int i = 4; i < 19; ++i) b4 = b4 + q[i];
                    const float sa = (a4.x + a4.y) + (a4.z + a4.w), sc = (q[2].x + q[2].y) + (q[2].z + q[2].w), sb = (b4.x + b4.y) + (b4.z + b4.w);
                    const float ra = 1.0f / sqrtf(sa * (1.f / 512.f) + EPS), rb = 1.0f / sqrtf(sb * (1.f / 256.f) + EPS), rc = 1.0f / sqrtf(sc * (1.f / 256.f) + EPS);
                    rs[tid * 3 + 0] = ra / rb; rs[tid * 3 + 1] = rb / rc; rs[tid * 3 + 2] = rc; } }
            __syncthreads();
            pg8::EpiResid E{X, mod + 2 * 1024, (DBG_STOP >= 1) ? 1.0f : 0.0f, nullptr};
            pg8::gemm_phase<pg8::EpiResid, pg8::GridOrder, true, false, true>(lds, g, S, E);
            if (l == 0 && bx >= 32) { __syncthreads(); cvt_expert_blocks(lds, ka, WGU, WD, wave, lane, 3072, 192 * TAIL_IN + (bx - 32), 224, 192 * TAIL_IN + 224 * TAIL_OUT, 1 << 30, 0); }
        }
        SEAM(P + 3);
        for (int rep_ = 0; rep_ < REPS(6) + REPS(11) - 1; ++rep_)
        if (IN(P + 4)) { PHASE_ENV_L
            LAS bf16_t* WRH = (LAS bf16_t*)lds;
            LAS bf16_t* WRL = WRH + 16384;
            LAS float* GAB = (LAS float*)(lds + 65536);
            LAS float* SHB = GAB + 1024;
            LAS float* GAC = SHB + 1024; LAS float* SHC = GAC + 1024;
            const int bwg = vcu >> 5;
            for (int idx = tid; idx < DM * 16; idx += 512) { const int k = idx >> 4, e = idx & 15; const float w = ka->w_router[((size_t)l * DM + k) * 16 + e];
                const unsigned hi = f2bf(w), lo = f2bf(w - bf2f((unsigned short)hi)); const int off = ((((k >> 5) * 4 + ((k >> 3) & 3)) * 16 + e) << 3) + (k & 7);
                WRH[off] = (bf16_t)hi; WRL[off] = (bf16_t)lo; }
            for (int k = tid; k < DM; k += 512) { const float gf = ka->g_ffn[l * DM + k]; const float* mr = mod + (size_t)bwg * 6144; GAB[k] = gf * (1.0f + mr[4 * 1024 + k]); SHB[k] = mr[3 * 1024 + k];
                if (l == 0) { const float* mc = mod + (size_t)8 * 6144; GAC[k] = gf * (1.0f + mc[4 * 1024 + k]); SHC[k] = mc[3 * 1024 + k]; } }
            __syncthreads();
            for (int pp = 0; pp < (l == 0 ? 2 : 1); ++pp) {
                const int r = lane & 15, g = lane >> 4;
                const bool valid = (pp == 0) || (r == 0);
                const int bb = (pp == 0) ? bwg : (gw >> 8); const int t0 = (pp == 0) ? (gw & 255) * 16 : SEQ + (gw & 255);
                const size_t mrow = (size_t)bb * TT + t0 + ((pp == 0) ? r : 0);
                const LAS float* GA = (pp == 0) ? GAB : GAC; const LAS float* SH = (pp == 0) ? SHB : SHC;
                const bf16_t* xrow = X + mrow * DM + 8 * g;
                float ss = 0.f;
#pragma unroll 8
                for (int c = 0; c < 32; ++c) { const u32x4 w = valid ? *(const u32x4*)(xrow + 32 * c) : (u32x4){0u, 0u, 0u, 0u};
                    ss += (bflo(w.x) * bflo(w.x) + bfhi(w.x) * bfhi(w.x)) + (bflo(w.y) * bflo(w.y) + bfhi(w.y) * bfhi(w.y)) + (bflo(w.z) * bflo(w.z) + bfhi(w.z) * bfhi(w.z)) + (bflo(w.w) * bflo(w.w) + bfhi(w.w) * bfhi(w.w)); }
                ss += shx(ss, 16, lane); ss += shx(ss, 32, lane);
                const float rstd = 1.0f / sqrtf(ss * (1.f / DM) + EPS);
                f32x4 acc = (f32x4){0.f, 0.f, 0.f, 0.f};
#pragma unroll 2
                for (int c = 0; c < 32; ++c) { const u32x4 w = valid ? *(const u32x4*)(xrow + 32 * c) : (u32x4){0u, 0u, 0u, 0u}; const int k0 = 32 * c + 8 * g;
                    const f32x4 ga0 = *(const LAS f32x4*)(GA + k0), ga1 = *(const LAS f32x4*)(GA + k0 + 4), sh0 = *(const LAS f32x4*)(SH + k0), sh1 = *(const LAS f32x4*)(SH + k0 + 4);
                    float h[8] = {bflo(w.x), bfhi(w.x), bflo(w.y), bfhi(w.y), bflo(w.z), bfhi(w.z), bflo(w.w), bfhi(w.w)};
                    h[0] = h[0] * rstd * ga0.x + sh0.x; h[1] = h[1] * rstd * ga0.y + sh0.y; h[2] = h[2] * rstd * ga0.z + sh0.z; h[3] = h[3] * rstd * ga0.w + sh0.w;
                    h[4] = h[4] * rstd * ga1.x + sh1.x; h[5] = h[5] * rstd * ga1.y + sh1.y; h[6] = h[6] * rstd * ga1.z + sh1.z; h[7] = h[7] * rstd * ga1.w + sh1.w;
                    u32x4 hi4; hi4.x = pk2(h[0], h[1]); hi4.y = pk2(h[2], h[3]); hi4.z = pk2(h[4], h[5]); hi4.w = pk2(h[6], h[7]);
                    u32x4 lo4; lo4.x = pk2(h[0] - bflo(hi4.x), h[1] - bfhi(hi4.x)); lo4.y = pk2(h[2] - bflo(hi4.y), h[3] - bfhi(hi4.y)); lo4.z = pk2(h[4] - bflo(hi4.z), h[5] - bfhi(hi4.z)); lo4.w = pk2(h[6] - bflo(hi4.w), h[7] - bfhi(hi4.w));
                    if (valid) { u32x2 h8; h8.x = pk4_fp8(h[0], h[1], h[2], h[3]); h8.y = pk4_fp8(h[4], h[5], h[6], h[7]); *(u32x2*)(H2 + mrow * DM + k0) = h8; }
                    const bf16x8 bh = *(const LAS bf16x8*)(WRH + (((c * 4 + g) * 16 + r) << 3)), bl = *(const LAS bf16x8*)(WRL + (((c * 4 + g) * 16 + r) << 3));
                    const bf16x8 ah = __builtin_bit_cast(bf16x8, hi4), al = __builtin_bit_cast(bf16x8, lo4);
                    acc = __builtin_amdgcn_mfma_f32_16x16x32_bf16(ah, bh, acc, 0, 0, 0);
                    acc = __builtin_amdgcn_mfma_f32_16x16x32_bf16(ah, bl, acc, 0, 0, 0);
                    acc = __builtin_amdgcn_mfma_f32_16x16x32_bf16(al, bh, acc, 0, 0, 0); }
                f32x4 av;
#pragma unroll
                for (int q = 0; q < 4; ++q) { const float x = acc[q]; float mx = x; mx = fmaxf(mx, shx(mx, 1, lane)); mx = fmaxf(mx, shx(mx, 2, lane)); mx = fmaxf(mx, shx(mx, 4, lane)); mx = fmaxf(mx, shx(mx, 8, lane));
                    const float ex = expf(x - mx); float den = ex; den += shx(den, 1, lane); den += shx(den, 2, lane); den += shx(den, 4, lane); den += shx(den, 8, lane); av[q] = ex / den; }
                float* ap = AFF + ((size_t)bb * NE + r) * TT + t0;
                if (pp == 0) *(f32x4*)(ap + 4 * g) = av;
                else if (g == 0) ap[0] = av[0];
            }
            __syncthreads();
        }
        SEAM(P + 4);
        for (int rep_ = 0; rep_ < REPS(6) + REPS(12) - 1; ++rep_)
        if (IN(P + 5)) { PHASE_ENV_L
            LAS unsigned* hist = (LAS unsigned*)lds;
            LAS unsigned* sh = hist + 256;
            const int nunits = (l == 0) ? 256 : 128;
            for (int u = vcu; u < nunits; u += G) { const int set = u >> 7, b = (u >> 4) & 7, e = u & 15;
                const int n = set ? CTX : SEQ, kk = set ? CAPC : CAP, t0 = set ? SEQ : 0;
                const float* ap = AFF + ((size_t)b * NE + e) * TT + t0;
                unsigned key[8]; const int nper = set ? 1 : 8; const bool act = set ? (tid < 256) : true;
#pragma unroll
                for (int i = 0; i < 8; ++i) key[i] = (act && i < nper) ? __float_as_uint(ap[tid * nper + i]) : 0u;
                unsigned prefix = 0u; unsigned krem = (unsigned)kk;
                for (int pass = 0; pass < 4; ++pass) { const int shift = 24 - 8 * pass;
                    if (tid < 256) hist[tid] = 0u;
                    __syncthreads();
#pragma unroll
                    for (int i = 0; i < 8; ++i) if (act && i < nper) { const unsigned kv = key[i]; const bool match = (pass == 0) || ((kv >> (shift + 8)) == prefix); if (match) __hip_atomic_fetch_add(&hist[(kv >> shift) & 255u], 1u, __ATOMIC_RELAXED, __HIP_MEMORY_SCOPE_WORKGROUP); }
                    __syncthreads();
                    if (wave == 0) {
                        const unsigned h0 = hist[4 * lane], h1 = hist[4 * lane + 1], h2 = hist[4 * lane + 2], h3 = hist[4 * lane + 3];
                        const unsigned tot = h0 + h1 + h2 + h3; unsigned suf = tot;
#pragma unroll
                        for (int o = 1; o < 64; o <<= 1) { const unsigned v = shidx(suf, (lane + o) & 63); if (lane + o < 64) suf += v; }
                        const unsigned above = suf - tot;
                        unsigned cum = above; int found = -1; unsigned cabove = 0;
                        if (found < 0 && cum + h3 >= krem && cum < krem) { found = 4 * lane + 3; cabove = cum; } cum += h3;
                        if (found < 0 && cum + h2 >= krem && cum < krem) { found = 4 * lane + 2; cabove = cum; } cum += h2;
                        if (found < 0 && cum + h1 >= krem && cum < krem) { found = 4 * lane + 1; cabove = cum; } cum += h1;
                        if (found < 0 && cum + h0 >= krem && cum < krem) { found = 4 * lane + 0; cabove = cum; }
                        if (found >= 0) { sh[0] = (prefix << 8) | (unsigned)found; sh[1] = krem - cabove; }
                    }
                    __syncthreads();
                    prefix = sh[0]; krem = sh[1];
                    __syncthreads();
                }
                unsigned cg = 0, ce = 0;
#pragma unroll
                for (int i = 0; i < 8; ++i) if (act && i < nper) { cg += key[i] > prefix; ce += key[i] == prefix; }
                unsigned packed = cg | (ce << 16);
                unsigned incl = packed;
#pragma unroll
                for (int o = 1; o < 64; o <<= 1) { const unsigned v = shidx(incl, (lane - o) & 63); if (lane >= o) incl += v; }
                if (lane == 63) sh[8 + wave] = incl;
                __syncthreads();
                unsigned wbase = 0, total = 0;
#pragma unroll
                for (int w2 = 0; w2 < 8; ++w2) { const unsigned s = sh[8 + w2]; if (w2 < wave) wbase += s; total += s; }
                const unsigned excl = wbase + incl - packed; unsigned og = excl & 0xffffu, oe = excl >> 16; const unsigned ngt = total & 0xffffu;
                const int slot0 = set ? (SEQ + b * CAPC) : (b * CAP);
#pragma unroll
                for (int i = 0; i < 8; ++i) if (act && i < nper) { const int tok = tid * nper + i; const int m = b * TT + t0 + tok; int slotrow = -1;
                    if (key[i] > prefix) { slotrow = slot0 + (int)og; ++og; }
                    else if (key[i] == prefix) { if (oe < krem) slotrow = slot0 + (int)(ngt + oe); ++oe; }
                    SEL[(size_t)m * NE + e] = slotrow;
                    if (slotrow >= 0) IDX[e * EROWS + slotrow] = m; }
                __syncthreads();
            }
        }
        SEAM(P + 5);
        for (int rep_ = 0; rep_ < REPS(4); ++rep_)
        if (IN(P + 6)) { PHASE_ENV_L
            pg8::Gemm g{(const bf16_t*)H2, (const bf16_t*)wgu, DM / 2}; pg8::MoeOrder S; S.init(l == 0 ? 17 : 16, 16, bx);
            pg8::EpiSwiGLU8 E{ACT, 1.0f / WSC8};
            pg8::gemm_phase<pg8::EpiSwiGLU8, pg8::MoeOrder, true, true, false, true>(lds, g, S, E, IDX);
        }
        SEAM(P + 6);
        for (int rep_ = 0; rep_ < REPS(5); ++rep_)
        if (IN(P + 7)) { PHASE_ENV_L
            pg8::Gemm g{(const bf16_t*)ACT, (const bf16_t*)wd, FF / 2}; pg8::MoeOrder S; S.init(l == 0 ? 17 : 16, 4, bx);
            pg8::EpiStoreS E{YS, DM, 1.0f / WSC8};
            pg8::gemm_phase<pg8::EpiStoreS, pg8::MoeOrder, true, false, false, true>(lds, g, S, E);
            if (l == 0 && bx >= 64) { __syncthreads(); cvt_expert_blocks(lds, ka, WGU, WD, wave, lane, 3072, 192 * TAIL_IN + 224 * TAIL_OUT + (bx - 64), 192, TAIL_BLKS, 1 << 30, 0); }
        }
        SEAM(P + 7);
        for (int rep_ = 0; rep_ < REPS(13); ++rep_)
        if (IN(P + 8)) { PHASE_ENV_L
            int ckey = -1; f32x4 g5[4], ga[4], sh[4];
#pragma unroll
            for (int j = 0; j < 4; ++j) { g5[j] = (f32x4){0.f, 0.f, 0.f, 0.f}; ga[j] = g5[j]; sh[j] = g5[j]; }
            f32x4 nv[4]; int nsel = -1; float naff = 0.f;
            const bool to_next = (l == 0 && DBG_STOP >= 3);
#define CMB_LOAD(mm) do { const int b_ = (mm) / TT, t_ = (mm) % TT; \
                _Pragma("unroll") for (int j = 0; j < 4; ++j) { const u32x2 xw_ = *(const u32x2*)(X + (size_t)(mm) * DM + 4 * lane + 256 * j); nv[j] = (f32x4){bflo(xw_.x), bfhi(xw_.x), bflo(xw_.y), bfhi(xw_.y)}; } \
                nsel = (lane < 16) ? SEL[(size_t)(mm) * NE + lane] : -1; naff = (lane < 16) ? AFF[((size_t)b_ * NE + lane) * TT + t_] : 0.f; } while (0)
            const int mbase = gw * 17;
            CMB_LOAD(mbase);
            for (int ri = 0; ri < 17; ++ri) { const int m = mbase + ri; const int b = m / TT, t = m % TT; const bool isctx = t >= SEQ;
                f32x4 v[4];
#pragma unroll
                for (int j = 0; j < 4; ++j) v[j] = nv[j];
                const int selv = nsel; const float affv = naff;
                if (ri < 16) CMB_LOAD(m + 1);
                if (l == 1 && isctx) continue;
                const int key = isctx ? 8 : b;
                if (key != ckey) { ckey = key; const float* mr5 = mod + (size_t)key * 6144 + 5 * 1024;
#pragma unroll
                    for (int j = 0; j < 4; ++j) { const int c = 4 * lane + 256 * j; g5[j] = *(const f32x4*)(mr5 + c);
                        if (to_next) { const float* mr = MOD + (size_t)9 * 6144 + (size_t)key * 6144; const f32x4 gv = *(const f32x4*)(ka->g_mix + DM + c), sc = *(const f32x4*)(mr + 1024 + c); ga[j] = gv * (sc + 1.0f); sh[j] = *(const f32x4*)(mr + c); }
                        else { ga[j] = *(const f32x4*)(ka->g_final + c); sh[j] = (f32x4){0.f, 0.f, 0.f, 0.f}; } } }
                if (DBG_STOP >= 2 + 2 * l) {
                f32x4 ma[4];
#pragma unroll
                for (int j = 0; j < 4; ++j) ma[j] = (f32x4){0.f, 0.f, 0.f, 0.f};
                unsigned mask = (unsigned)__ballot(selv >= 0) & 0xffffu;
                while (mask) {
                    int sr[4]; float gt[4];
#if YS_F8
                    const unsigned char* yr[4];
#else
                    const bf16_t* yr[4];
#endif
#pragma unroll
                    for (int u = 0; u < 4; ++u) { const bool has = mask != 0u; const int e = has ? (__builtin_ffs((int)mask) - 1) : 0; if (has) mask &= mask - 1u;
                        sr[u] = __builtin_amdgcn_readlane(selv, e); gt[u] = __builtin_bit_cast(float, __builtin_amdgcn_readlane(__builtin_bit_cast(int, affv), e));
                        if (!has) { sr[u] = 0; gt[u] = 0.f; }
#if YS_F8
                        yr[u] = (const unsigned char*)YS + ((size_t)e * EROWS + sr[u]) * DM; }
                    unsigned w[4][4];
#pragma unroll
                    for (int u = 0; u < 4; ++u)
#pragma unroll
                        for (int j = 0; j < 4; ++j) w[u][j] = *(const unsigned*)(yr[u] + 4 * lane + 256 * j);
#pragma unroll
                    for (int u = 0; u < 4; ++u)
#pragma unroll
                        for (int j = 0; j < 4; ++j) { const f32x2 lo_ = __builtin_amdgcn_cvt_pk_f32_fp8((int)w[u][j], false), hi_ = __builtin_amdgcn_cvt_pk_f32_fp8((int)w[u][j], true);
                            ma[j].x += gt[u] * lo_[0]; ma[j].y += gt[u] * lo_[1]; ma[j].z += gt[u] * hi_[0]; ma[j].w += gt[u] * hi_[1]; }
#else
                        yr[u] = YS + ((size_t)e * EROWS + sr[u]) * DM; }
                    u32x2 w[4][4];
#pragma unroll
                    for (int u = 0; u < 4; ++u)
#pragma unroll
                        for (int j = 0; j < 4; ++j) w[u][j] = *(const u32x2*)(yr[u] + 4 * lane + 256 * j);
#pragma unroll
                    for (int u = 0; u < 4; ++u)
#pragma unroll
                        for (int j = 0; j < 4; ++j) { ma[j].x += gt[u] * bflo(w[u][j].x); ma[j].y += gt[u] * bfhi(w[u][j].x); ma[j].z += gt[u] * bflo(w[u][j].y); ma[j].w += gt[u] * bfhi(w[u][j].y); }
#endif
                }
#pragma unroll
                for (int j = 0; j < 4; ++j) v[j] = v[j] + g5[j] * ma[j];
                }
                if (to_next) {
#pragma unroll
                    for (int j = 0; j < 4; ++j) { u32x2 xw; xw.x = pk2(v[j].x, v[j].y); xw.y = pk2(v[j].z, v[j].w); *(u32x2*)(((REPS(13) > 1 && rep_ == 0) ? QKV : X) + (size_t)m * DM + 4 * lane + 256 * j) = xw; }
                }
                if (to_next || !isctx) {
                    float ss = 0.f;
#pragma unroll
                    for (int j = 0; j < 4; ++j) ss += (v[j].x * v[j].x + v[j].y * v[j].y) + (v[j].z * v[j].z + v[j].w * v[j].w);
                    const float r = 1.0f / sqrtf(wave_sum(ss, lane) * (1.f / DM) + EPS);
#pragma unroll
                    for (int j = 0; j < 4; ++j) v[j] = v[j] * r * ga[j] + sh[j];
                    if (to_next) { if (INPROJ_F8) store_row_fp8(H + (size_t)m * DM, v, lane); else store_row_bf16((bf16_t*)H + (size_t)m * DM, v, lane); }
                    else {
#pragma unroll
                        for (int j = 0; j < 4; ++j) *(f32x4*)(ka->out + ((size_t)b * SEQ + t) * DM + 4 * lane + 256 * j) = v[j]; }
                }
            }
#undef CMB_LOAD
        }
        if (l == 0) SEAM(P + 8);
    }
#undef IN
#undef SEAM
}

extern "C" void kernel_launch(void* const* d_in, const int* in_sizes, int n_in, void* d_out, int out_size, void* d_ws, size_t ws_size, hipStream_t stream) {
    static int grid = 0;
    if (grid == 0) {
        if (n_in != 21 || out_size != NB * SEQ * DM || ws_size < WS_END) { fprintf(stderr, "kernel_launch: unexpected problem (n_in %d, out %d, ws %zu)\n", n_in, out_size, ws_size); grid = -1; return; }
        int dev = 0, cus = 0, per_cu = 0;
        if (hipGetDevice(&dev) != hipSuccess || hipDeviceGetAttribute(&cus, hipDeviceAttributeMultiprocessorCount, dev) != hipSuccess) { grid = -1; return; }
        if (hipFuncSetAttribute((const void*)fwd_kernel, hipFuncAttributeMaxDynamicSharedMemorySize, LDS_BYTES) != hipSuccess) { fprintf(stderr, "kernel_launch: hipFuncSetAttribute failed\n"); grid = -1; return; }
        if (hipOccupancyMaxActiveBlocksPerMultiprocessor(&per_cu, (const void*)fwd_kernel, NWAVES * 64, LDS_BYTES) != hipSuccess || per_cu < 1) fprintf(stderr, "kernel_launch: occupancy query reports %d\n", per_cu);
        (void)hipGetLastError();
        grid = cus;
        if (grid != 256) { fprintf(stderr, "kernel_launch: built for 256 CUs, got %d\n", grid); grid = -1; return; }
    }
    if (grid < 0) return;
    if (hipMemsetAsync((char*)d_ws + WS_CTL, 0, CTL_ZERO_BYTES, stream) != hipSuccess) return;
    Args a{};
    const float** ap = (const float**)&a;
    for (int i = 0; i < 21; ++i) ap[i] = (const float*)d_in[i];
    a.out = (float*)d_out; a.ws = (unsigned char*)d_ws;
#if MK_PER_PHASE
    for (int p = 0; p < NPHASE; ++p) { a.ph_lo = p; a.ph_hi = p + 1; hipLaunchKernelGGL(fwd_kernel, dim3(grid), dim3(NWAVES * 64), LDS_BYTES, stream, a); }
#else
    a.ph_lo = 0; a.ph_hi = NPHASE;
    hipLaunchKernelGGL(fwd_kernel, dim3(grid), dim3(NWAVES * 64), LDS_BYTES, stream, a);
#endif
}
```

```cpp
#include <hip/hip_runtime.h>
#include <hip/hip_bf16.h>
#include <cstdio>
#include <cstdint>

#ifndef MK_PER_PHASE
#define MK_PER_PHASE 0
#endif
#ifndef DBG_STOP
#define DBG_STOP 99
#endif
#ifndef DBG_GROUPS
#define DBG_GROUPS 7
#endif

#ifndef F8MODE
#define F8MODE 2
#endif
#ifndef INPROJ_F8
#define INPROJ_F8 1
#endif
#ifndef ATT_F8
#define ATT_F8 1
#endif
#ifndef PV_F8
#define PV_F8 1
#endif
#ifndef DMA_ROLES
#define DMA_ROLES 1
#endif
#ifndef YS_F8
#define YS_F8 1
#endif
#ifndef G_SADDR
#define G_SADDR 1
#endif
#ifndef G_FRESH
#define G_FRESH 1
#endif
#ifndef G_RO1
#define G_RO1 1
#endif
#ifndef G_UNI
#define G_UNI 0
#endif
#ifndef G_NORON
#define G_NORON 1
#endif
#ifndef G_SBASE
#define G_SBASE 1
#endif
#ifndef PROBE_DUP
#define PROBE_DUP 0
#endif
#define REPS(k) ((PROBE_DUP == (k)) ? 2 : 1)
#define GAS __attribute__((address_space(1)))
#define LAS __attribute__((address_space(3)))
typedef unsigned short bf16_t;
typedef short bf16x8 __attribute__((ext_vector_type(8)));
typedef short s16x4 __attribute__((ext_vector_type(4)));
typedef float f32x2 __attribute__((ext_vector_type(2)));
typedef float f32x4 __attribute__((ext_vector_type(4)));
typedef float f32x16 __attribute__((ext_vector_type(16)));
typedef unsigned u32x2 __attribute__((ext_vector_type(2)));
typedef unsigned u32x4 __attribute__((ext_vector_type(4)));
typedef int i32x4v __attribute__((ext_vector_type(4)));
typedef int i32x8v __attribute__((ext_vector_type(8)));
typedef int i32x2v __attribute__((ext_vector_type(2)));
typedef long i64x2v __attribute__((ext_vector_type(2)));

constexpr int NB = 8, SEQ = 4096, CTX = 256, TT = SEQ + CTX  , MROWS = NB * TT  , DM = 1024;
constexpr int NQ = 2048;
constexpr int C_QA = 0, C_KA = 512, C_VA = 640, C_VR = 768, C_VI = 1024, C_QN = 1280, C_KN = 1536, C_VN = 1792;
constexpr size_t MR_ = (size_t)8 * 4352;
constexpr size_t O_QA = 0, O_KA = MR_ * 512, O_VA = O_KA + MR_ * 128, O_VRI = O_VA + MR_ * 128, O_QN = O_VRI + MR_ * 512, O_KN = O_QN + MR_ * 256, O_VN = O_KN + MR_ * 256;
constexpr int NE = 16, FF = 2048, CAP = 512, CAPC = 32;
constexpr int ERT = 17;
constexpr int EROWS = ERT * 256;
constexpr float EPS = 1e-6f;
constexpr float LOG2E = 1.4426950408889634f;
constexpr float WSC8 = 64.0f;
constexpr float C2 = 0.125f * LOG2E;

constexpr size_t MiB = 1u << 20;
constexpr size_t WS_CTL = 0, CTL_ZERO_BYTES = 1 * MiB;
constexpr size_t WS_MODP = 1 * MiB;
constexpr size_t WS_MOD = 5 * MiB;
constexpr size_t WS_TAB = 6 * MiB;
constexpr size_t TAB_ROPE = 0, TAB_M1 = 8192, TAB_W3 = 8192 + 32768, TAB_TW = 8192 + 32768 + 16384, TAB_TWC = TAB_TW + 32768, TAB_CSC = 131072  ;
constexpr size_t WS_AFF = 7 * MiB;
constexpr size_t WS_SEL = 10 * MiB;
constexpr size_t WS_IDX = 13 * MiB;
constexpr size_t WS_WIN = 16 * MiB;
constexpr size_t WS_WOUT = 24 * MiB;
constexpr size_t WS_WGU = 28 * MiB;
constexpr size_t WS_WD = 284 * MiB;
constexpr size_t WS_X = 412 * MiB;
constexpr size_t WS_R = 548 * MiB;
constexpr size_t WS_QKV = WS_R, WS_OCAT = WS_R + 136 * MiB, WS_H = WS_R + 204 * MiB, WS_ACT = WS_R;
constexpr size_t WS_YS = 820 * MiB;
constexpr size_t WS_H2 = WS_YS;
constexpr size_t WS_XE = WS_YS;
constexpr size_t WS_ST = 960 * MiB;
constexpr size_t WS_END = 972 * MiB;

constexpr int CW_TMO = 0, CW_Q0 = 64  , CW_BAR = 4096;

constexpr int RING_BYTES = 149504;
constexpr int RS_OFF = 131072;
constexpr int GI_OFF = 131072;
constexpr int LDSCTL_OFF = RING_BYTES, MISC_OFF = LDSCTL_OFF + 320;
constexpr int LDS_BYTES = 151552;

#define LDS_WAIT() asm volatile("s_waitcnt lgkmcnt(0)" ::: "memory")
#define VM_WAIT() asm volatile("s_waitcnt vmcnt(0)" ::: "memory")
__device__ __forceinline__ unsigned f2bf(float f) { unsigned u = __builtin_bit_cast(unsigned, f); return (u + 0x7fffu + ((u >> 16) & 1u)) >> 16; }
typedef __bf16 hwbf16x2_t __attribute__((ext_vector_type(2)));
__device__ __forceinline__ unsigned pk2(float lo, float hi) { f32x2 v = {lo, hi}; hwbf16x2_t b = __builtin_convertvector(v, hwbf16x2_t); return __builtin_bit_cast(unsigned, b); }
__device__ __forceinline__ unsigned pk4_fp8(float a, float b, float c, float d) { int w; asm volatile("" : "=v"(w));
    w = __builtin_amdgcn_cvt_pk_fp8_f32(a, b, w, false); w = __builtin_amdgcn_cvt_pk_fp8_f32(c, d, w, true); return (unsigned)w; }
__device__ __forceinline__ float bf2f(unsigned short h) { return __builtin_bit_cast(float, (unsigned)h << 16); }
__device__ __forceinline__ float bflo(unsigned w) { return __builtin_bit_cast(float, w << 16); }
__device__ __forceinline__ float bfhi(unsigned w) { return __builtin_bit_cast(float, w & 0xffff0000u); }
__device__ __forceinline__ int tid_fresh() { int t = threadIdx.x; asm volatile("" : "+v"(t)); return t; }
__device__ __forceinline__ float shx(float v, int mask, int lane) { return __builtin_bit_cast(float, __builtin_amdgcn_ds_bpermute((lane ^ mask) << 2, __builtin_bit_cast(int, v))); }
__device__ __forceinline__ unsigned shidx(unsigned v, int src_lane) { return (unsigned)__builtin_amdgcn_ds_bpermute(src_lane << 2, (int)v); }
__device__ __forceinline__ float wave_sum(float v, int lane) { (void)lane;
#define WS_DPP(x, ctrl) __builtin_bit_cast(float, __builtin_amdgcn_update_dpp(0, __builtin_bit_cast(int, x), ctrl, 0xf, 0xf, false))
    v += WS_DPP(v, 0xB1);
    v += WS_DPP(v, 0x4E);
    v += WS_DPP(v, 0x141);
    v += WS_DPP(v, 0x140);
#undef WS_DPP
    const int vi = __builtin_bit_cast(int, v);
    const float r0 = __builtin_bit_cast(float, __builtin_amdgcn_readlane(vi, 0)), r1 = __builtin_bit_cast(float, __builtin_amdgcn_readlane(vi, 16)),
                r2 = __builtin_bit_cast(float, __builtin_amdgcn_readlane(vi, 32)), r3 = __builtin_bit_cast(float, __builtin_amdgcn_readlane(vi, 48));
    return (r0 + r1) + (r2 + r3);
}

namespace pg8 {
constexpr int BM = 256, BK = 64, HALF = 128, HTB = HALF * BK * 2, NXCD = 8;
__host__ __device__ __forceinline__ int lds_byte(int r, int c) { const int st = (r >> 4) * 2 + (c >> 5), rr = r & 15, cc = c & 31, ob = rr * 64 + cc * 2; return st * 1024 + (ob ^ (((ob >> 9) & 1) << 5)); }
__host__ __device__ __forceinline__ void stage_rc(int b, int& R, int& C) { const int st = b / 1024, sb = b % 1024, swz = sb ^ (((sb >> 9) & 1) << 5); R = (st >> 1) * 16 + swz / 64; C = (st & 1) * 32 + (swz % 64) / 2; }
__host__ __device__ __forceinline__ int perm32(int rho) { const int n = rho >> 4, i = rho & 15; return 8 * (i >> 2) + 4 * n + (i & 3); }

struct Unit { int pm, pn, pb; };
struct Gemm { const bf16_t* A; const bf16_t* Bt; int K; };

__device__ __forceinline__ unsigned cvt_pk_bf16(float lo, float hi) { unsigned r; asm volatile("v_cvt_pk_bf16_f32 %0, %1, %2" : "=v"(r) : "v"(lo), "v"(hi)); return r; }

template <class Epi, class Sched, bool ALIGN_EPI = false, bool GATHER = false, bool KSCALE = false, bool F8 = false>
__device__ __forceinline__ void gemm_phase(LAS unsigned char* lds, const Gemm g, const Sched& S, Epi E, const int* gidx = nullptr) {
    const int tid = tid_fresh(), wid = __builtin_amdgcn_readfirstlane(tid >> 6), lane = tid & 63, wr = wid >> 2, wc = wid & 3, fr = lane & 15, fq = lane >> 4;
    const int K = g.K, nt = K / BK;
    unsigned voffB;
    { int R, C; stage_rc(tid * 16, R, C); const int Rb = ((R & ~31) + perm32(R & 31)); voffB = (unsigned)(Rb * K + C) * 2u; }
    const unsigned rowb = (unsigned)K * 2u;
    unsigned voffA = 0; if constexpr (!GATHER && G_SBASE) { int R, C; stage_rc(tid * 16, R, C); voffA = (unsigned)R * rowb + (unsigned)C * 2u; }
#define PG8_ROWOFF(dst, pm_, uo_) do { if constexpr (!GATHER && G_SBASE) { _Pragma("unroll") for (int h_ = 0; h_ < 2; ++h_) { dst[h_][0] = (unsigned)((pm_) * BM + h_ * HALF) * rowb; dst[h_][1] = 0u; } } else { \
        const int tq_ = G_FRESH ? tid_fresh() : tid; _Pragma("unroll") for (int i_ = 0; i_ < 2; ++i_) { int R_, C_; stage_rc(tq_ * 16 + i_ * 8192, R_, C_); \
        _Pragma("unroll") for (int h_ = 0; h_ < 2; ++h_) { const int r_ = (pm_) * BM + h_ * HALF + R_; dst[h_][i_] = (unsigned)(GATHER ? ((const LAS int*)(lds + GI_OFF))[(uo_) * 256 + h_ * HALF + R_] : r_) * rowb + (unsigned)C_ * 2u; } } } } while (0)
    const size_t kstep = (size_t)(BK * 2);
    const size_t hstep = (size_t)HALF * K * 2;
    const size_t tstep = 2 * hstep;
    const unsigned ldsw = (unsigned)wid * 1024u;
    const int aoff = lds_byte(wr * 64 + fr, fq * 8), boff = lds_byte(wc * 32 + fr, fq * 8);
#define PG8_SA(b, h) (((b) * 2 + (h)) * HTB)
#define PG8_SB(b, h) ((4 + (b) * 2 + (h)) * HTB)
#if G_SADDR
#define PG8_OPQ(x) ({ unsigned o_ = (x); asm volatile("" : "+v"(o_)); o_; })
#if G_UNI
#define PG8_UNI(p) ({ const char* p_ = (p); asm volatile("" : "+s"(p_)); p_; })
#else
#define PG8_UNI(p) (p)
#endif
#else
#define PG8_OPQ(x) (x)
#define PG8_UNI(p) (p)
#endif
#define PG8_STAGE(bufoff, gbase, voff) do { _Pragma("unroll") for (int _i = 0; _i < 2; ++_i) \
        __builtin_amdgcn_global_load_lds((const unsigned*)(PG8_UNI((const char*)(gbase) + (size_t)_i * 64 * rowb) + PG8_OPQ(voff)), (LAS unsigned*)(lds + (bufoff) + ldsw + _i * 8192), 16, 0, 0); } while (0)
#define PG8_STAGE_A(bufoff, ro, h, koff) do { _Pragma("unroll") for (int _i = 0; _i < 2; ++_i) \
        __builtin_amdgcn_global_load_lds((const unsigned*)(PG8_UNI((const char*)g.A + (size_t)(koff) + (GATHER ? (size_t)0 : (size_t)_i * 64 * rowb + (G_SBASE ? (size_t)(ro)[h][0] : (size_t)0))) + PG8_OPQ(GATHER ? (ro)[h][_i] : (G_SBASE ? voffA : (ro)[h][0]))), (LAS unsigned*)(lds + (bufoff) + ldsw + _i * 8192), 16, 0, 0); } while (0)
#define PG8_LDA(dst, b, h) do { _Pragma("unroll") for (int m = 0; m < 4; ++m) _Pragma("unroll") for (int k = 0; k < 2; ++k) dst[m][k] = *(const LAS bf16x8*)(lds + PG8_SA(b, h) + aoff + m * 2048 + k * 1024); } while (0)
#define PG8_LDB(dst, b, h) do { _Pragma("unroll") for (int n = 0; n < 2; ++n) _Pragma("unroll") for (int k = 0; k < 2; ++k) dst[n][k] = *(const LAS bf16x8*)(lds + PG8_SB(b, h) + boff + n * 2048 + k * 1024); } while (0)
#define PG8_CAT(x0, x1) __builtin_shufflevector(__builtin_bit_cast(i32x4v, x0), __builtin_bit_cast(i32x4v, x1), 0, 1, 2, 3, 4, 5, 6, 7)
#define PG8_MMA(ai, bj, At, Bt) do { __builtin_amdgcn_s_setprio(1); _Pragma("unroll") for (int m = 0; m < 4; ++m) _Pragma("unroll") for (int n = 0; n < 2; ++n) { \
        if constexpr (F8 && F8MODE == 2) { const i32x8v b8_ = PG8_CAT(Bt[n][0], Bt[n][1]), a8_ = PG8_CAT(At[m][0], At[m][1]); acc[ai][bj][m][n] = __builtin_amdgcn_mfma_scale_f32_16x16x128_f8f6f4(b8_, a8_, acc[ai][bj][m][n], 0, 0, 0, 0, 0, 0); } \
        else if constexpr (F8) { _Pragma("unroll") for (int k = 0; k < 2; ++k) { const i64x2v b2_ = __builtin_bit_cast(i64x2v, Bt[n][k]), a2_ = __builtin_bit_cast(i64x2v, At[m][k]); \
            acc[ai][bj][m][n] = __builtin_amdgcn_mfma_f32_16x16x32_fp8_fp8(b2_[0], a2_[0], acc[ai][bj][m][n], 0, 0, 0); acc[ai][bj][m][n] = __builtin_amdgcn_mfma_f32_16x16x32_fp8_fp8(b2_[1], a2_[1], acc[ai][bj][m][n], 0, 0, 0); } } \
        else { _Pragma("unroll") for (int k = 0; k < 2; ++k) acc[ai][bj][m][n] = __builtin_amdgcn_mfma_f32_16x16x32_bf16(Bt[n][k], At[m][k], acc[ai][bj][m][n], 0, 0, 0); } } __builtin_amdgcn_s_setprio(0); } while (0)
#define PG8_WAIT_V(n) asm volatile("s_waitcnt vmcnt(" #n ")" ::: "memory")
#define PG8_WAIT_L(n) asm volatile("s_waitcnt lgkmcnt(" #n ")" ::: "memory")
#define PG8_BAR __builtin_amdgcn_s_barrier()
#define PG8_SCHED __builtin_amdgcn_sched_barrier(0)
    Unit cur, nxt; int ui = 0;
    if (!S.next(0, cur)) return;
    f32x4 acc[2][2][4][2];
#pragma unroll
    for (int a = 0; a < 2; ++a)
#pragma unroll
        for (int b = 0; b < 2; ++b)
#pragma unroll
            for (int m = 0; m < 4; ++m)
#pragma unroll
                for (int n = 0; n < 2; ++n) acc[a][b][m][n] = (f32x4){0.f, 0.f, 0.f, 0.f};
    bf16x8 At[4][2], B0[2][2], B1[2][2];
    unsigned roC[2][2], roN[2][2];
    if constexpr (GATHER) {
        Unit u_; for (int i_ = 0; i_ < 17 && S.next(i_, u_); ++i_) { if (tid < 256) ((LAS int*)(lds + GI_OFF))[i_ * 256 + tid] = gidx[u_.pm * BM + tid]; }
        __syncthreads(); }
    PG8_ROWOFF(roC, cur.pm, 0);
    const char* cB = (const char*)g.Bt + (size_t)cur.pb * tstep;
    {
        PG8_STAGE(PG8_SB(0, 0), cB, voffB); PG8_STAGE(PG8_SB(0, 1), cB + hstep, voffB); PG8_STAGE_A(PG8_SA(0, 0), roC, 0, 0); PG8_STAGE_A(PG8_SA(0, 1), roC, 1, 0);
        if (wr == 1) PG8_BAR;
        PG8_WAIT_V(2); PG8_BAR;
        PG8_STAGE(PG8_SB(1, 0), cB + kstep, voffB); PG8_STAGE_A(PG8_SA(1, 0), roC, 0, kstep); PG8_STAGE(PG8_SB(1, 1), cB + hstep + kstep, voffB);
        PG8_WAIT_V(6); PG8_BAR;
    }
    for (;;) {
        const bool has_next = S.next(ui + 1, nxt);
        const char* nB = has_next ? (const char*)g.Bt + (size_t)nxt.pb * tstep : cB;
        if constexpr (GATHER) {
            if (G_NORON) {}
            else if (has_next) PG8_ROWOFF(roN, nxt.pm, ui + 1);
            else {
#pragma unroll
                for (int h_ = 0; h_ < 2; ++h_)
#pragma unroll
                    for (int i_ = 0; i_ < 2; ++i_) roN[h_][i_] = roC[h_][i_]; } }
        for (int seg = 0; seg < (KSCALE ? 3 : 1); ++seg) {
        const int tb = KSCALE ? (seg == 0 ? 0 : (seg == 1 ? 8 : 12)) : 0, te = KSCALE ? (seg == 0 ? 8 : (seg == 1 ? 12 : nt)) : nt;
        if constexpr (KSCALE) { if (seg > 0) { const LAS float* rs = (const LAS float*)(lds + RS_OFF) + ui * 768 + (seg - 1);
#pragma unroll
                for (int a = 0; a < 2; ++a)
#pragma unroll
                    for (int m = 0; m < 4; ++m) { const float f = rs[(a * HALF + wr * 64 + m * 16 + fr) * 3];
#pragma unroll
                        for (int b = 0; b < 2; ++b)
#pragma unroll
                            for (int n = 0; n < 2; ++n) acc[a][b][m][n] = acc[a][b][m][n] * f; } } }
        for (int t = tb; t < te; t += 2) {
            const bool last = (t == nt - 2);
            const size_t k1 = (size_t)(t + 1) * kstep;
            const size_t k2 = last ? (size_t)0 : (size_t)(t + 2) * kstep, k3 = k2 + kstep;
            const char* b2 = last ? nB : cB + (size_t)(t + 2) * kstep; const char* b3 = b2 + kstep;
            constexpr bool RO1 = GATHER && G_NORON && G_RO1;
            unsigned ro2[2][2];
            if constexpr (!RO1) {
#pragma unroll
            for (int h_ = 0; h_ < 2; ++h_)
#pragma unroll
                for (int i_ = 0; i_ < 2; ++i_) ro2[h_][i_] = roC[h_][i_]; }
            auto& roU = *(RO1 ? &roC : &ro2);
            if (!RO1 && last) {
                if constexpr (!GATHER) { const int pmn = has_next ? nxt.pm : cur.pm; PG8_ROWOFF(ro2, pmn, 0);
                    if constexpr (G_SBASE) { asm volatile("" : "+s"(ro2[0][0]), "+s"(ro2[1][0])); }
                    else {
#pragma unroll
                    for (int h_ = 0; h_ < 2; ++h_)
#pragma unroll
                        for (int i_ = 0; i_ < 2; ++i_) asm volatile("" : "+v"(ro2[h_][i_])); } }
                else if constexpr (G_NORON) { const int uo2 = has_next ? ui + 1 : ui; PG8_ROWOFF(ro2, 0, uo2);
#pragma unroll
                    for (int h_ = 0; h_ < 2; ++h_)
#pragma unroll
                        for (int i_ = 0; i_ < 2; ++i_) asm volatile("" : "+v"(ro2[h_][i_])); }
                else {
#pragma unroll
                    for (int h_ = 0; h_ < 2; ++h_)
#pragma unroll
                        for (int i_ = 0; i_ < 2; ++i_) { asm volatile("" : "+v"(roN[h_][i_])); ro2[h_][i_] = roN[h_][i_]; } } }
            PG8_LDB(B0, 0, 0); PG8_LDB(B1, 0, 1); PG8_SCHED; PG8_LDA(At, 0, 0); PG8_STAGE_A(PG8_SA(1, 1), roC, 1, k1);
            if constexpr (RO1) { if (last) { const int uo2 = has_next ? ui + 1 : ui; PG8_ROWOFF(roC, 0, uo2);
#pragma unroll
                    for (int h_ = 0; h_ < 2; ++h_)
#pragma unroll
                        for (int i_ = 0; i_ < 2; ++i_) asm volatile("" : "+v"(roC[h_][i_])); } }
            PG8_WAIT_V(8); PG8_WAIT_L(0); PG8_BAR; PG8_MMA(0, 0, At, B0); PG8_MMA(0, 1, At, B1); PG8_BAR; PG8_SCHED;
            PG8_LDA(At, 0, 1); PG8_STAGE(PG8_SB(0, 0), b2, voffB); PG8_STAGE(PG8_SB(0, 1), b2 + hstep, voffB); PG8_STAGE_A(PG8_SA(0, 0), roU, 0, k2);
            PG8_WAIT_V(8); PG8_WAIT_L(0); PG8_BAR; PG8_MMA(1, 0, At, B0); PG8_MMA(1, 1, At, B1); PG8_BAR; PG8_SCHED;
            PG8_LDB(B0, 1, 0); PG8_LDB(B1, 1, 1); PG8_SCHED; PG8_LDA(At, 1, 0); PG8_STAGE_A(PG8_SA(0, 1), roU, 1, k2);
            PG8_WAIT_V(8); PG8_WAIT_L(0); PG8_BAR; PG8_MMA(0, 0, At, B0); PG8_MMA(0, 1, At, B1); PG8_BAR; PG8_SCHED;
            PG8_LDA(At, 1, 1); PG8_STAGE(PG8_SB(1, 0), b3, voffB); PG8_STAGE(PG8_SB(1, 1), b3 + hstep, voffB); PG8_STAGE_A(PG8_SA(1, 0), roU, 0, k3);
            PG8_WAIT_V(8); PG8_WAIT_L(0); PG8_BAR; PG8_MMA(1, 0, At, B0); PG8_MMA(1, 1, At, B1); PG8_BAR; PG8_SCHED;
        }
        }
        if constexpr (ALIGN_EPI) { if (wr == 0) PG8_BAR; }
        if constexpr (KSCALE) E.rs3 = (const LAS float*)(lds + RS_OFF) + ui * 768 + 2;
        if constexpr (G_FRESH) { const int te_ = tid_fresh(), le_ = te_ & 63, we_ = __builtin_amdgcn_readfirstlane(te_ >> 6); E(acc, cur, we_ >> 2, we_ & 3, le_ & 15, le_ >> 4); }
        else E(acc, cur, wr, wc, fr, fq);
        if (!has_next) break;
#pragma unroll
        for (int a = 0; a < 2; ++a)
#pragma unroll
            for (int b = 0; b < 2; ++b)
#pragma unroll
                for (int m = 0; m < 4; ++m)
#pragma unroll
                    for (int n = 0; n < 2; ++n) acc[a][b][m][n] = (f32x4){0.f, 0.f, 0.f, 0.f};
        cur = nxt; cB = nB; ++ui;
        if constexpr (GATHER && !G_NORON) {
#pragma unroll
            for (int h_ = 0; h_ < 2; ++h_)
#pragma unroll
                for (int i_ = 0; i_ < 2; ++i_) roC[h_][i_] = roN[h_][i_]; }
        else PG8_ROWOFF(roC, cur.pm, ui);
        if constexpr (ALIGN_EPI) { if (wr == 1) PG8_BAR; }
    }
    PG8_WAIT_V(0);
    if constexpr (!ALIGN_EPI) { if (wr == 0) PG8_BAR; }
    PG8_BAR;
#undef PG8_SA
#undef PG8_SB
#undef PG8_STAGE
#undef PG8_STAGE_A
#undef PG8_ROWOFF
#undef PG8_LDA
#undef PG8_LDB
#undef PG8_MMA
#undef PG8_OPQ
#undef PG8_UNI
#undef PG8_CAT
#undef PG8_WAIT_V
#undef PG8_WAIT_L
#undef PG8_BAR
#undef PG8_SCHED
}

struct GridOrder {
    int nM, nN, nwg, G, c, skipctx;
    __device__ __forceinline__ void init(int nM_, int nN_, int G_, int c_, int skipctx_) { nM = nM_; nN = nN_; nwg = nM * nN; G = G_; c = c_; skipctx = skipctx_; }
    __device__ __forceinline__ bool next(int i, Unit& u) const {
        const long L = (long)i * G + c; if (L >= nwg) return false;
        int wgid = (int)L; { const int q = nwg / NXCD, r = nwg % NXCD, xcd = wgid % NXCD, off = wgid / NXCD; wgid = (xcd < r ? xcd * (q + 1) : r * (q + 1) + (xcd - r) * q) + off; }
        const int WGM = 8; const int nig = WGM * nN, gid = wgid / nig, fm = gid * WGM, gsz = (nM - fm) < WGM ? (nM - fm) : WGM;
        int pm = fm + ((wgid % nig) % gsz); u.pn = (wgid % nig) / gsz; u.pb = u.pn;
        if (skipctx) pm = (pm >> 4) * 17 + (pm & 15);
        u.pm = pm; return true;
    }
};
struct MoeOrder {
    int rt, ct, x, ci, upe;
    __device__ __forceinline__ void init(int rt_, int ct_, int c_) { rt = rt_; ct = ct_; x = c_ & 7; ci = c_ >> 3; upe = rt * ct; }
    __device__ __forceinline__ bool next(int i, Unit& u) const {
        const int j = i * 32 + ci; if (j >= 2 * upe) return false;
        const int e = 2 * x + j / upe, w = j % upe;
        const int nig = 4 * ct, gid = w / nig, fm = gid * 4, gsz = (rt - fm) < 4 ? (rt - fm) : 4;
        const int pml = fm + ((w % nig) % gsz), pnl = (w % nig) / gsz;
        u.pm = e * ERT + pml; u.pn = pnl; u.pb = e * ct + pnl; return true;
    }
};

struct EpiStore {
    bf16_t* O; int ldc;
    __device__ __forceinline__ void operator()(const f32x4 (&acc)[2][2][4][2], const Unit& u, int wr, int wc, int fr, int fq) const {
        const int row0 = u.pm * BM + wr * 64 + fr, col0 = u.pn * BM + wc * 32 + 8 * fq;
#pragma unroll
        for (int ai = 0; ai < 2; ++ai)
#pragma unroll
            for (int m = 0; m < 4; ++m) { bf16_t* rowp = O + (size_t)(row0 + ai * HALF + m * 16) * ldc + col0;
#pragma unroll
                for (int bj = 0; bj < 2; ++bj) { const f32x4 v0 = acc[ai][bj][m][0], v1 = acc[ai][bj][m][1];
                    u32x4 w; w.x = cvt_pk_bf16(v0[0], v0[1]); w.y = cvt_pk_bf16(v0[2], v0[3]); w.z = cvt_pk_bf16(v1[0], v1[1]); w.w = cvt_pk_bf16(v1[2], v1[3]);
                    *(u32x4*)(rowp + bj * HALF) = w; } }
    }
};
struct EpiStoreS {
    bf16_t* O; int ldc; float sc;
    __device__ __forceinline__ void operator()(const f32x4 (&acc)[2][2][4][2], const Unit& u, int wr, int wc, int fr, int fq) const {
        const int row0 = u.pm * BM + wr * 64 + fr, col0 = u.pn * BM + wc * 32 + 8 * fq;
#pragma unroll
        for (int ai = 0; ai < 2; ++ai)
#pragma unroll
            for (int m = 0; m < 4; ++m) { bf16_t* rowp = O + (size_t)(row0 + ai * HALF + m * 16) * ldc + col0;
#pragma unroll
                for (int bj = 0; bj < 2; ++bj) { const f32x4 v0 = acc[ai][bj][m][0] * sc, v1 = acc[ai][bj][m][1] * sc;
#if YS_F8
                    u32x2 w8; w8.x = pk4_fp8(v0[0], v0[1], v0[2], v0[3]); w8.y = pk4_fp8(v1[0], v1[1], v1[2], v1[3]);
                    *(u32x2*)((unsigned char*)O + ((size_t)(row0 + ai * HALF + m * 16) * ldc + col0 + bj * HALF)) = w8; (void)rowp;
#else
                    u32x4 w; w.x = cvt_pk_bf16(v0[0], v0[1]); w.y = cvt_pk_bf16(v0[2], v0[3]); w.z = cvt_pk_bf16(v1[0], v1[1]); w.w = cvt_pk_bf16(v1[2], v1[3]);
                    *(u32x4*)(rowp + bj * HALF) = w;
#endif
                } }
    }
};
struct EpiInProj {
    bf16_t* QKVb; const float* gq; const float* gk; const float* rope; float sc;
    __device__ __forceinline__ void operator()(const f32x4 (&acc)[2][2][4][2], const Unit& u, int wr, int wc, int fr, int fq) const {
        const int it = u.pm % 17, pn = u.pn; const bool isctx = (it == 16);
        const int row0 = u.pm * BM + wr * 64 + fr;
        const bool headed = (pn < 2) || (pn == 2 && wc < 2);
        if (!headed) {
            bf16_t* base; int ldc, col, bjs;
            if (pn == 2) { base = QKVb + O_VA; ldc = 128; col = (wc - 2) * 64 + 8 * fq; bjs = 32; }
            else if (pn <= 4) { base = QKVb + O_VRI; ldc = 512; col = (pn - 3) * 256 + wc * 32 + 8 * fq; bjs = 128; }
            else { base = QKVb + (pn == 5 ? O_QN : (pn == 6 ? O_KN : O_VN)); ldc = 256; col = wc * 32 + 8 * fq; bjs = 128; }
#pragma unroll
            for (int ai = 0; ai < 2; ++ai)
#pragma unroll
                for (int m = 0; m < 4; ++m) { bf16_t* rowp = base + (size_t)(row0 + ai * HALF + m * 16) * ldc + col;
#pragma unroll
                    for (int bj = 0; bj < 2; ++bj) { const f32x4 v0 = acc[ai][bj][m][0] * sc, v1 = acc[ai][bj][m][1] * sc;
                        if ((ATT_F8 && (pn == 5 || pn == 6)) || (PV_F8 && (pn == 2 || pn == 7))) { u32x2 w8; w8.x = pk4_fp8(v0[0], v0[1], v0[2], v0[3]); w8.y = pk4_fp8(v1[0], v1[1], v1[2], v1[3]);
                            *(u32x2*)((unsigned char*)base + ((size_t)(row0 + ai * HALF + m * 16) * ldc + col + bj * bjs)) = w8; }
                        else {
                        u32x4 w; w.x = cvt_pk_bf16(v0[0], v0[1]); w.y = cvt_pk_bf16(v0[2], v0[3]); w.z = cvt_pk_bf16(v1[0], v1[1]); w.w = cvt_pk_bf16(v1[2], v1[3]);
                        *(u32x4*)(rowp + bj * bjs) = w; } } }
        } else {
            const bool isq = pn < 2; const float* g = isq ? gq : gk;
            bf16_t* base = QKVb + (isq ? O_QA : O_KA); const int ldc = isq ? 512 : 128; const int col = (isq ? (pn * 4 + wc) : wc) * 64 + 8 * fq;
            const int lanev = fq * 16 + fr; const float qs = isq ? C2 : 1.0f; const bool hi_half = (fq >> 1) != 0;
            f32x4 gv[2][2];
#pragma unroll
            for (int bj = 0; bj < 2; ++bj)
#pragma unroll
                for (int n = 0; n < 2; ++n) gv[bj][n] = *(const f32x4*)(g + 32 * bj + 8 * fq + 4 * n);
            f32x4 rco[2][2], rsi[2][2];
            if (!isctx) {
#pragma unroll
                for (int ai = 0; ai < 2; ++ai) { const int pos = it * 4 + ai * 2 + wr;
#pragma unroll
                    for (int n = 0; n < 2; ++n) { const float* cs = rope + (pos * 16 + 8 * (fq & 1) + 4 * n) * 2; const f32x4 c01 = *(const f32x4*)cs, c23 = *(const f32x4*)(cs + 4);
                        rco[ai][n] = (f32x4){c01.x, c01.z, c23.x, c23.z}; const f32x4 sv = (f32x4){c01.y, c01.w, c23.y, c23.w}; rsi[ai][n] = hi_half ? sv : -sv; } } }
#pragma unroll
            for (int m = 0; m < 4; ++m) {
                f32x4 cco[2], csi[2];
                if (!isctx) { const int pos = m * 16 + fr;
#pragma unroll
                    for (int n = 0; n < 2; ++n) { const float* cs = rope + (pos * 16 + 8 * (fq & 1) + 4 * n) * 2; const f32x4 c01 = *(const f32x4*)cs, c23 = *(const f32x4*)(cs + 4);
                        cco[n] = (f32x4){c01.x, c01.z, c23.x, c23.z}; const f32x4 sv = (f32x4){c01.y, c01.w, c23.y, c23.w}; csi[n] = hi_half ? sv : -sv; } }
#pragma unroll
                for (int ai = 0; ai < 2; ++ai) {
                    f32x4 v[2][2]; float ss = 0.f;
#pragma unroll
                    for (int bj = 0; bj < 2; ++bj)
#pragma unroll
                        for (int n = 0; n < 2; ++n) { const f32x4 a_ = acc[ai][bj][m][n]; ss += (a_[0] * a_[0] + a_[1] * a_[1]) + (a_[2] * a_[2] + a_[3] * a_[3]); v[bj][n] = a_ * gv[bj][n]; }
                    ss += shx(ss, 16, lanev); ss += shx(ss, 32, lanev);
                    const float R = (sc * qs) / sqrtf(ss * (sc * sc * (1.f / 64.f)) + EPS);
                    if (!isctx) {
#pragma unroll
                        for (int bj = 0; bj < 2; ++bj)
#pragma unroll
                            for (int n = 0; n < 2; ++n) { const f32x4 co = (bj == 0) ? rco[ai][n] : cco[n], si = (bj == 0) ? rsi[ai][n] : csi[n];
#pragma unroll
                                for (int j = 0; j < 4; ++j) { const float own = v[bj][n][j];
                                    auto sw = __builtin_amdgcn_permlane32_swap(__builtin_bit_cast(unsigned, own), __builtin_bit_cast(unsigned, own), false, false);
                                    const float oth = __builtin_bit_cast(float, hi_half ? sw[0] : sw[1]);
                                    v[bj][n][j] = own * co[j] + oth * si[j]; } } }
#pragma unroll
                    for (int bj = 0; bj < 2; ++bj) { const f32x4 v0 = v[bj][0] * R, v1 = v[bj][1] * R;
#if ATT_F8
                        u32x2 w8; w8.x = pk4_fp8(v0[0], v0[1], v0[2], v0[3]); w8.y = pk4_fp8(v1[0], v1[1], v1[2], v1[3]);
                        *(u32x2*)((unsigned char*)base + ((size_t)(row0 + ai * HALF + m * 16) * ldc + col + bj * 32)) = w8;
#else
                        bf16_t* rowp = base + (size_t)(row0 + ai * HALF + m * 16) * ldc + col;
                        u32x4 w; w.x = cvt_pk_bf16(v0[0], v0[1]); w.y = cvt_pk_bf16(v0[2], v0[3]); w.z = cvt_pk_bf16(v1[0], v1[1]); w.w = cvt_pk_bf16(v1[2], v1[3]);
                        *(u32x4*)(rowp + bj * 32) = w;
#endif
                    } } }
        }
    }
};
struct EpiSwiGLU {
    bf16_t* O;
    __device__ __forceinline__ void operator()(const f32x4 (&acc)[2][2][4][2], const Unit& u, int wr, int wc, int fr, int fq) const {
        const int row0 = u.pm * BM + wr * 64 + fr, col0 = u.pn * HALF + wc * 32 + 8 * fq;
#pragma unroll
        for (int ai = 0; ai < 2; ++ai)
#pragma unroll
            for (int m = 0; m < 4; ++m) { bf16_t* rowp = O + (size_t)(row0 + ai * HALF + m * 16) * FF + col0;
                float r[8];
#pragma unroll
                for (int n = 0; n < 2; ++n)
#pragma unroll
                    for (int j = 0; j < 4; ++j) { const float gt = acc[ai][0][m][n][j], up = acc[ai][1][m][n][j];
                        const float sg = gt * __builtin_amdgcn_rcpf(1.0f + __builtin_amdgcn_exp2f(-gt * LOG2E)); r[n * 4 + j] = sg * up; }
                u32x4 w; w.x = cvt_pk_bf16(r[0], r[1]); w.y = cvt_pk_bf16(r[2], r[3]); w.z = cvt_pk_bf16(r[4], r[5]); w.w = cvt_pk_bf16(r[6], r[7]);
                *(u32x4*)rowp = w; }
    }
};
struct EpiSwiGLU8 {
    unsigned char* O; float sc;
    __device__ __forceinline__ void operator()(const f32x4 (&acc)[2][2][4][2], const Unit& u, int wr, int wc, int fr, int fq) const {
        const int row0 = u.pm * BM + wr * 64 + fr, col0 = u.pn * HALF + wc * 32 + 8 * fq;
#pragma unroll
        for (int ai = 0; ai < 2; ++ai)
#pragma unroll
            for (int m = 0; m < 4; ++m) { unsigned char* rowp = O + (size_t)(row0 + ai * HALF + m * 16) * FF + col0;
                float r[8];
#pragma unroll
                for (int n = 0; n < 2; ++n)
#pragma unroll
                    for (int j = 0; j < 4; j += 2) {
                        const f32x2 ga_ = {acc[ai][0][m][n][j], acc[ai][0][m][n][j + 1]}, ua_ = {acc[ai][1][m][n][j], acc[ai][1][m][n][j + 1]};
                        const f32x2 t_ = ga_ * (-sc * LOG2E); f32x2 d_ = {__builtin_amdgcn_exp2f(t_[0]), __builtin_amdgcn_exp2f(t_[1])}; d_ = d_ + 1.0f;
                        f32x2 q_ = {__builtin_amdgcn_rcpf(d_[0]), __builtin_amdgcn_rcpf(d_[1])}; q_ = q_ * (sc * sc);
                        const f32x2 o_ = (ga_ * ua_) * q_; r[n * 4 + j] = o_[0]; r[n * 4 + j + 1] = o_[1]; }
                u32x2 w; w.x = pk4_fp8(r[0], r[1], r[2], r[3]); w.y = pk4_fp8(r[4], r[5], r[6], r[7]);
                *(u32x2*)rowp = w; }
    }
};
struct EpiResid {
    bf16_t* Xs; const float* gate  ; float gsc; const LAS float* rs3;
    __device__ __forceinline__ void operator()(const f32x4 (&acc)[2][2][4][2], const Unit& u, int wr, int wc, int fr, int fq) const {
        const int b = u.pm / 17, it = u.pm % 17; const bool isctx = (it == 16);
        const float* gp = gate + (size_t)(isctx ? 8 : b) * 6144;
        const int col0 = u.pn * BM + wc * 32 + 8 * fq;
        bf16_t* base = Xs + ((size_t)u.pm * BM + wr * 64 + fr) * DM + col0;
        u32x4 xw[2][4][2];
#pragma unroll
        for (int ai = 0; ai < 2; ++ai)
#pragma unroll
            for (int m = 0; m < 4; ++m)
#pragma unroll
                for (int bj = 0; bj < 2; ++bj) xw[ai][m][bj] = *(const u32x4*)(base + (size_t)(ai * HALF + m * 16) * DM + bj * HALF);
        f32x4 g0[2], g1[2];
#pragma unroll
        for (int bj = 0; bj < 2; ++bj) { g0[bj] = *(const f32x4*)(gp + col0 + bj * HALF); g1[bj] = *(const f32x4*)(gp + col0 + bj * HALF + 4); }
#pragma unroll
        for (int ai = 0; ai < 2; ++ai)
#pragma unroll
            for (int m = 0; m < 4; ++m) { const int rr = ai * HALF + wr * 64 + m * 16 + fr; const float f3 = gsc * rs3[rr * 3];
#pragma unroll
                for (int bj = 0; bj < 2; ++bj) { const u32x4 xv = xw[ai][m][bj];
                    const f32x4 x0 = (f32x4){bflo(xv.x), bfhi(xv.x), bflo(xv.y), bfhi(xv.y)}, x1 = (f32x4){bflo(xv.z), bfhi(xv.z), bflo(xv.w), bfhi(xv.w)};
                    const f32x4 y0 = x0 + g0[bj] * f3 * acc[ai][bj][m][0], y1 = x1 + g1[bj] * f3 * acc[ai][bj][m][1];
                    u32x4 w; w.x = cvt_pk_bf16(y0[0], y0[1]); w.y = cvt_pk_bf16(y0[2], y0[3]); w.z = cvt_pk_bf16(y1[0], y1[1]); w.w = cvt_pk_bf16(y1[2], y1[3]);
                    *(u32x4*)(base + (size_t)(ai * HALF + m * 16) * DM + bj * HALF) = w; } }
    }
};
}

namespace attn {
using bf16 = __hip_bfloat16;
constexpr int NW = 8, QBLK = 32, KVBLK = 64;
constexpr int OP = DM;
__device__ __forceinline__ int crow(int r, int hi) { return (r & 3) + 8 * (r >> 2) + 4 * hi; }
#define SBAR() __builtin_amdgcn_sched_barrier(0)
constexpr int NSLOT = 3, SLOTB = 8192;
constexpr int LDS_K = 0, LDS_V = NSLOT * SLOTB, LDS_WS = 2 * NSLOT * SLOTB, LDS_OST = LDS_WS + NW * 64 * 4, LDS_BYTES = LDS_OST + NW * 4096;
constexpr int LDS_RB = 86016;
constexpr int LDS_KSCR = 98304;
__device__ __forceinline__ void glds16(const void* gsrc, unsigned lds_dst) { unsigned keep;
  asm volatile("s_mov_b32 %0, m0\n\ts_mov_b32 m0, %2\n\ts_nop 0\n\tglobal_load_lds_dwordx4 %1, off\n\ts_mov_b32 m0, %0" : "=&s"(keep) : "v"(gsrc), "s"(lds_dst) : "memory"); }
__device__ __forceinline__ float max3f(float a, float b, float c) { float r; asm("v_max3_f32 %0, %1, %2, %3" : "=v"(r) : "v"(a), "v"(b), "v"(c)); return r; }
__device__ __forceinline__ float max2f(float a, float b) { float r; asm("v_max_f32_e32 %0, %1, %2" : "=v"(r) : "v"(a), "v"(b)); return r; }
__device__ __forceinline__ float fadd_s(float a, float b) { float r; asm("v_add_f32_e32 %0, %1, %2" : "=v"(r) : "v"(a), "v"(b)); return r; }
__device__ __forceinline__ float fsub_s(float a, float b) { float r; asm("v_sub_f32_e32 %0, %1, %2" : "=v"(r) : "v"(a), "v"(b)); return r; }
typedef __bf16 bf16x2_t __attribute__((ext_vector_type(2)));
__device__ __forceinline__ unsigned cvtpk_s(float lo, float hi) { f32x2 v = {lo, hi}; bf16x2_t b = __builtin_convertvector(v, bf16x2_t); return __builtin_bit_cast(unsigned, b); }
#define WAIT_BAR(N) asm volatile("s_waitcnt vmcnt(" #N ") lgkmcnt(0)\n\ts_barrier" ::: "memory")
#if PV_F8 && DMA_ROLES
#define WAIT_STEADY() WAIT_BAR(1)
#else
#define WAIT_STEADY() WAIT_BAR(2)
#endif
__device__ __forceinline__ void qkt(f32x16& p0, f32x16& p1, const char* Kslot, const bf16x8* qr, const f32x16& negm, int r32, int hi) {
  const char* kb = Kslot + hi * 1024 + r32 * 16;
#pragma unroll
  for (int d0 = 0; d0 < 4; ++d0) {
    const bf16x8 b0 = *reinterpret_cast<const bf16x8*>(kb + d0 * 2048);
    const bf16x8 b1 = *reinterpret_cast<const bf16x8*>(kb + d0 * 2048 + 512);
    if (d0 == 0) { p0 = __builtin_amdgcn_mfma_f32_32x32x16_bf16(b0, qr[0], negm, 0, 0, 0); p1 = __builtin_amdgcn_mfma_f32_32x32x16_bf16(b1, qr[0], negm, 0, 0, 0); }
    else { p0 = __builtin_amdgcn_mfma_f32_32x32x16_bf16(b0, qr[d0], p0, 0, 0, 0); p1 = __builtin_amdgcn_mfma_f32_32x32x16_bf16(b1, qr[d0], p1, 0, 0, 0); } }
}
typedef LAS const char* lds_cptr;
typedef short v4i16_t __attribute__((ext_vector_type(4)));
__device__ __forceinline__ void kload8(bf16x8* kf, lds_cptr kp) {
  kf[0] = *(const LAS bf16x8*)(kp);        kf[1] = *(const LAS bf16x8*)(kp + 512);
  kf[2] = *(const LAS bf16x8*)(kp + 2048); kf[3] = *(const LAS bf16x8*)(kp + 2560);
  kf[4] = *(const LAS bf16x8*)(kp + 4096); kf[5] = *(const LAS bf16x8*)(kp + 4608);
  kf[6] = *(const LAS bf16x8*)(kp + 6144); kf[7] = *(const LAS bf16x8*)(kp + 6656);
}
__device__ __forceinline__ void kload2(bf16x8* kf, lds_cptr kp, int j) { kf[2 * j] = *(const LAS bf16x8*)(kp + j * 2048); kf[2 * j + 1] = *(const LAS bf16x8*)(kp + j * 2048 + 512); }
__device__ __forceinline__ s16x4 vtr(lds_cptr p) { return __builtin_bit_cast(s16x4, __builtin_amdgcn_ds_read_tr16_b64_v4i16((LAS v4i16_t*)p)); }
__device__ __forceinline__ float rowmax(const f32x16& p0, const f32x16& p1) {
  float a = max3f(p0[0], p0[1], p1[0]), b = max3f(p0[2], p0[3], p1[1]); a = max3f(a, p1[2], p1[3]);
#pragma unroll
  for (int r = 4; r < 16; r += 4) { a = max3f(a, p0[r], p0[r + 1]); b = max3f(b, p0[r + 2], p0[r + 3]); a = max3f(a, p1[r], p1[r + 1]); b = max3f(b, p1[r + 2], p1[r + 3]); }
  const float m = max2f(a, b);
  auto rr = __builtin_amdgcn_permlane32_swap(__float_as_uint(m), __float_as_uint(m), false, false);
  return max2f(__uint_as_float(rr[0]), __uint_as_float(rr[1]));
}
__device__ __forceinline__ void pv(f32x16* o, int vb, bf16x8 pa0, bf16x8 pa1, bf16x8 pa2, bf16x8 pa3) {
#pragma unroll
  for (int d0 = 0; d0 < 2; ++d0) { s16x4 lo[4], hi[4];
#pragma unroll
    for (int ks = 0; ks < 4; ++ks) {
      asm volatile("ds_read_b64_tr_b16 %0,%1 offset:%c2" : "=&v"(lo[ks]) : "v"(vb), "i"(d0 * 4096 + ks * 1024) : "memory");
      asm volatile("ds_read_b64_tr_b16 %0,%1 offset:%c2" : "=&v"(hi[ks]) : "v"(vb), "i"(d0 * 4096 + ks * 1024 + 512) : "memory"); }
    asm volatile("s_waitcnt lgkmcnt(0)" ::: "memory"); SBAR();
#define PK(k) (bf16x8){lo[k][0], lo[k][1], lo[k][2], lo[k][3], hi[k][0], hi[k][1], hi[k][2], hi[k][3]}
    o[d0] = __builtin_amdgcn_mfma_f32_32x32x16_bf16(pa0, PK(0), o[d0], 0, 0, 0);
    o[d0] = __builtin_amdgcn_mfma_f32_32x32x16_bf16(pa1, PK(1), o[d0], 0, 0, 0);
    o[d0] = __builtin_amdgcn_mfma_f32_32x32x16_bf16(pa2, PK(2), o[d0], 0, 0, 0);
    o[d0] = __builtin_amdgcn_mfma_f32_32x32x16_bf16(pa3, PK(3), o[d0], 0, 0, 0);
#undef PK
  }
}
template <bool NA> __device__ __forceinline__ void na_hook(f32x16& P0, f32x16& P1, int t, int T0, int n_win, int kr_lo, int qr, int c, int hi, const LAS float* rb) {
  if constexpr (NA) {
    if (t >= T0) {
      const int w = t - T0, kr = kr_lo + w;
      int rs = qr - 4; rs = rs < 0 ? 0 : (rs > 56 ? 56 : rs);
      const bool rowok = (w < n_win) && (kr >= rs) && (kr < rs + 8);
      if (!rowok) {
#pragma unroll
        for (int r = 0; r < 16; ++r) { P0[r] = -INFINITY; P1[r] = -INFINITY; }
      } else {
        int cs = c - 8; cs = cs < 0 ? 0 : (cs > 48 ? 48 : cs);
        const LAS float* rbp = rb + (kr - qr + 7) * 128 + (63 - c) + 4 * hi;
        const int d0 = 4 * hi - cs;
#pragma unroll
        for (int r = 0; r < 16; ++r) { const int kc0 = (r & 3) + 8 * (r >> 2);
          const float b0 = rbp[kc0], b1 = rbp[kc0 + 32];
          P0[r] = ((unsigned)(kc0 + d0) < 16u) ? P0[r] + b0 : -INFINITY;
          P1[r] = ((unsigned)(kc0 + 32 + d0) < 16u) ? P1[r] + b1 : -INFINITY; }
      }
    }
  }
}
template <int THRL, bool NA, int QP, int KP> __device__ __forceinline__ void attn_unit(const bf16* Qw0, const bf16* __restrict__ Kh, const bf16* __restrict__ Vh, bf16* Ow0, char* shm,
                                                                        int NT, int T0, int row0, int row1, int nvalid, int qr0, int kr_lo, int n_win, float* st0  ) {
  const int tid = tid_fresh(), lane = tid & 63, r32 = lane & 31, hi = lane >> 5; const int wid = __builtin_amdgcn_readfirstlane(tid >> 6);
  const bf16* Qw = Qw0 + (long)(wid * QBLK) * QP;
  const unsigned lds0 = (unsigned)(uintptr_t)shm;
  float* wsf = (float*)(shm + LDS_WS) + wid * 64;
#if ATT_F8
  const unsigned char* Qw8 = (const unsigned char*)Qw0 + (long)(wid * QBLK) * QP;
  const unsigned char* ksrc = (const unsigned char*)Kh + (long)lane * KP + (wid & 3) * 16;
#else
  const bf16* ksrc = Kh + (long)lane * KP + wid * 8;
#endif
#if PV_F8
  const int vrho_ = 16 * (wid & 3) + (lane >> 2), vkey_ = 16 * ((vrho_ >> 3) & 3) + 8 * ((vrho_ & 7) >> 2) + 4 * (vrho_ >> 5) + (vrho_ & 3);
  const unsigned char* vsrc = (const unsigned char*)Vh + (long)vkey_ * KP + (lane & 3) * 16;
#else
  const bf16* vsrc = Vh + (long)(16 * (wid & 3) + (lane >> 2)) * KP + (wid >> 2) * 32 + (lane & 3) * 8;
#endif
#if ATT_F8
  const int kslotm = (wid < 4) ? -1 : 0;
  const unsigned kdst = lds0 + (wid < 4 ? LDS_K + wid * 1024 : LDS_KSCR + (wid & 3) * 1024);
#if PV_F8 && DMA_ROLES
  const unsigned vdst = lds0 + LDS_V + (wid & 3) * 1024;
#elif PV_F8
  const unsigned vdst = lds0 + (wid < 4 ? LDS_V + wid * 1024 : LDS_KSCR + 4096 + (wid & 3) * 1024);
#else
  const unsigned vdst = lds0 + LDS_V + wid * 1024;
#endif
#else
  const unsigned kdst = lds0 + LDS_K + wid * 1024, vdst = lds0 + LDS_V + wid * 1024;
#endif
#define TROW(t) (!NA ? row0 + 64 * (t) : ((t) < T0 ? row0 + 64 * (t) : row1 + 64 * ((((t) < nvalid) ? (t) : nvalid - 1) - T0)))
#if ATT_F8 && PV_F8 && DMA_ROLES
#define DMA_K(t, slot) do { if (wid < 4) glds16(ksrc + (long)TROW(t) * KP, (unsigned)__builtin_amdgcn_readfirstlane(kdst + (slot))); } while (0)
#elif ATT_F8
#define DMA_K(t, slot) glds16(ksrc + (long)TROW(t) * KP, (unsigned)__builtin_amdgcn_readfirstlane(kdst + ((slot) & kslotm)))
#else
#define DMA_K(t, slot) glds16(ksrc + (long)TROW(t) * KP, (unsigned)__builtin_amdgcn_readfirstlane(kdst + (slot)))
#endif
#if PV_F8 && DMA_ROLES
#define DMA_V(t, slot) do { if (wid >= 4) glds16(vsrc + (long)TROW(t) * KP, (unsigned)__builtin_amdgcn_readfirstlane(vdst + (slot))); } while (0)
#elif PV_F8
#define DMA_V(t, slot) glds16(vsrc + (long)TROW(t) * KP, (unsigned)__builtin_amdgcn_readfirstlane(vdst + ((slot) & kslotm)))
#else
#define DMA_V(t, slot) glds16(vsrc + (long)TROW(t) * KP, (unsigned)__builtin_amdgcn_readfirstlane(vdst + (slot)))
#endif
  const int vb0 = (int)(lds0 + LDS_V) + ((lane >> 4) & 1) * 32 + (lane & 3) * 8 + (4 * hi + ((lane & 15) >> 2)) * 64;
#if ATT_F8
  i32x8v k8[2];
  const lds_cptr shm3 = (lds_cptr)shm; const lds_cptr kp0 = shm3 + LDS_K + hi * 2048 + r32 * 16;
#if PV_F8
  const lds_cptr vp0 = shm3 + LDS_V + (32 * hi + ((lane & 15) >> 1)) * 64 + ((lane >> 4) & 1) * 16 + (lane & 1) * 8;
#else
  const lds_cptr vp0 = shm3 + LDS_V + ((lane >> 4) & 1) * 32 + (lane & 3) * 8 + (4 * hi + ((lane & 15) >> 2)) * 64;
#endif
#define K8LD(dst, kp_, s_) dst = __builtin_shufflevector(*(const LAS i32x4v*)((kp_) + (s_) * 512), *(const LAS i32x4v*)((kp_) + 1024 + (s_) * 512), 0, 1, 2, 3, 4, 5, 6, 7)
#define QK8(kk, cc) __builtin_amdgcn_mfma_scale_f32_32x32x64_f8f6f4(kk, q8, cc, 0, 0, 0, 0, 0, 0)
#else
  const char* Kbase = shm + LDS_K; bf16x8 kf[8];
  const lds_cptr shm3 = (lds_cptr)shm; const lds_cptr kp0 = shm3 + LDS_K + hi * 1024 + r32 * 16;
  const lds_cptr vp0 = shm3 + LDS_V + ((lane >> 4) & 1) * 32 + (lane & 3) * 8 + (4 * hi + ((lane & 15) >> 2)) * 64;
#endif
  const LAS float* rb = (const LAS float*)(shm3 + LDS_RB);
  const int qr = qr0 + (wid >> 1), qc = 32 * (wid & 1) + r32;
  DMA_K(0, 0); DMA_V(0, 0); DMA_K(1, SLOTB);
#if ATT_F8
  const i32x8v q8 = __builtin_shufflevector(*(const i32x4v*)(Qw8 + (long)r32 * QP + hi * 32), *(const i32x4v*)(Qw8 + (long)r32 * QP + hi * 32 + 16), 0, 1, 2, 3, 4, 5, 6, 7);
#else
  bf16x8 qrg[4];
#pragma unroll
  for (int d0 = 0; d0 < 4; ++d0) qrg[d0] = *reinterpret_cast<const bf16x8*>(&Qw[(long)r32 * QP + d0 * 16 + hi * 8]);
#endif
  float mhat = 0.f; f32x16 o[2]; o[0] = f32x16{}; o[1] = f32x16{}; f32x16 negm = f32x16{}; asm volatile("" : "+v"(negm));
  f32x4 lacc = (f32x4){0.f, 0.f, 0.f, 0.f};
  const unsigned osel_ = ((((lane >> 4) & 1) == 0) == ((lane & 15) < 8)) ? 0x3F803F80u : 0u;
  const bf16x8 ones = __builtin_bit_cast(bf16x8, (u32x4){osel_, osel_, osel_, osel_});
#define LROW0() ({ int ll_ = lane; asm volatile("" : "+v"(ll_)); 4 * (ll_ >> 4) + (((ll_ & 15) >= 8) ? 16 : 0); })
#define CMASK(P0, P1, t) na_hook<NA>(P0, P1, (t), T0, n_win, kr_lo, qr, qc, hi, rb)
  bool resc = false;
#define START(P0, P1) do { const float rm = rowmax(P0, P1); resc = false; \
    { const float dl = rm; mhat = fadd_s(mhat, dl); \
      _Pragma("unroll") for (int r = 0; r < 16; ++r) { P0[r] = fsub_s(P0[r], dl); P1[r] = fsub_s(P1[r], dl); } \
      _Pragma("unroll") for (int r = 0; r < 16; ++r) negm[r] = -mhat; asm volatile("" : "+v"(negm)); } \
    _Pragma("unroll") for (int r = 0; r < 16; ++r) P0[r] = __builtin_amdgcn_exp2f(P0[r]); } while (0)
#define RESC() do { if (resc) { asm volatile("s_waitcnt lgkmcnt(0)" ::: "memory"); \
      _Pragma("unroll") for (int d_ = 0; d_ < 2; ++d_) _Pragma("unroll") for (int r = 0; r < 16; ++r) o[d_][r] *= wsf[crow(r, hi)]; \
      { const int lr0_ = LROW0(); _Pragma("unroll") for (int r = 0; r < 4; ++r) lacc[r] *= wsf[lr0_ + r]; } } } while (0)
  f32x16 pA0, pA1, pB0, pB1;
  int sl_prev = 0, sl_cur = 0, sl_next = SLOTB;
#define ROT() do { sl_prev = sl_cur; sl_cur = sl_next; sl_next = (sl_next == (NSLOT - 1) * SLOTB) ? 0 : sl_next + SLOTB; } while (0)
  DMA_K(2, 2 * SLOTB);
#if PV_F8 && DMA_ROLES
  WAIT_BAR(2);
#else
  WAIT_BAR(3);
#endif
#if ATT_F8
  K8LD(k8[0], kp0, 0); K8LD(k8[1], kp0, 1); pA0 = QK8(k8[0], negm); pA1 = QK8(k8[1], negm);
#else
  qkt(pA0, pA1, Kbase, qrg, negm, r32, hi);
#endif
  asm volatile("s_nop 15\n\ts_nop 7" : "+v"(pA0), "+v"(pA1)); CMASK(pA0, pA1, 0);
  START(pA0, pA1);
  _Pragma("unroll") for (int r = 0; r < 16; ++r) pA1[r] = __builtin_amdgcn_exp2f(pA1[r]);
  WAIT_BAR(0);
  DMA_K(3, 0); DMA_V(1, SLOTB);
  ROT();
#if ATT_F8
  K8LD(k8[0], kp0 + sl_cur, 0); K8LD(k8[1], kp0 + sl_cur, 1);
#else
  kload8(kf, kp0 + sl_cur);
#endif
  WAIT_BAR(2);
#if PV_F8
  i32x2v vv[8]; u32x4 p8lo, p8hi;
  const unsigned s8_ = osel_ ? 0x38383838u : 0u; const i32x8v sel8 = (i32x8v){(int)s8_, (int)s8_, (int)s8_, (int)s8_, (int)s8_, (int)s8_, (int)s8_, (int)s8_};
#define PK4(P, B) pk4_fp8(P[B], P[B + 1], P[B + 2], P[B + 3])
#define P8() __builtin_shufflevector(__builtin_bit_cast(i32x4v, p8lo), __builtin_bit_cast(i32x4v, p8hi), 0, 1, 2, 3, 4, 5, 6, 7)
#define V8(d0) ((i32x8v){vv[4 * (d0)][0], vv[4 * (d0)][1], vv[4 * (d0) + 1][0], vv[4 * (d0) + 1][1], vv[4 * (d0) + 2][0], vv[4 * (d0) + 2][1], vv[4 * (d0) + 3][0], vv[4 * (d0) + 3][1]})
#define PVM(d0) o[d0] = __builtin_amdgcn_mfma_scale_f32_32x32x64_f8f6f4(P8(), V8(d0), o[d0], 0, 0, 0, 0, 0, 0)
#define LSUM() __builtin_amdgcn_mfma_scale_f32_16x16x128_f8f6f4(P8(), sel8, lacc, 0, 0, 0, 0, 0, 0)
#define GAPA8(MF, W0, PW) do { MF; W0; PIN(PW); SBAR(); } while (0)
#else
  s16x4 vlo[8], vhi[8]; u32x4 pw0, pw1, pw2, pw3;
#endif
#define PKW(P, B) cvtpk_s(P[B], P[B + 1])
#define PAF(k) __builtin_bit_cast(bf16x8, pw##k)
#define VFR(i) (bf16x8){vlo[i][0], vlo[i][1], vlo[i][2], vlo[i][3], vhi[i][0], vhi[i][1], vhi[i][2], vhi[i][3]}
#define PIN(x) asm volatile("" : "+v"(x))
#define MX3(a, b, c) __builtin_fmaxf(__builtin_fmaxf((a), (b)), (c))
#define GAPA(MF, A0, A1, A2, A3, W0, W1, PW) do { MF; W0; W1; PIN(PW); SBAR(); } while (0)
#define EX(v) __builtin_amdgcn_exp2f(v)
#define GAPB(MF, X, B) do { MF; X[B] = EX(X[B]); X[B + 1] = EX(X[B + 1]); X[B + 2] = EX(X[B + 2]); X[B + 3] = EX(X[B + 3]); PIN(X); SBAR(); } while (0)
#if PV_F8
#define VRD(i) vv[i] = __builtin_amdgcn_ds_read_tr8_b64_v2i32((LAS i32x2v*)(vp_ + (((i) >> 2) * 32 + ((i) & 3) * 512)))
#else
#define VRD(i) do { vlo[i] = vtr(vp_ + (((i) >> 2) * 4096 + ((i) & 3) * 1024)); vhi[i] = vtr(vp_ + (((i) >> 2) * 4096 + ((i) & 3) * 1024 + 512)); } while (0)
#endif
#if ATT_F8
#define KRD(G, j) do { if ((G) && (j) < 2) { K8LD(k8[j], kp0 + sl_next, j); SBAR(); } } while (0)
#define QKM(C, i, acc_) do { if ((i) == 0) C = QK8(k8[0], negm); else if ((i) == 1) C = QK8(k8[1], negm); } while (0)
#else
#define KRD(G, j) do { if (G) { kload2(kf, kp0 + sl_next, j); SBAR(); } } while (0)
#define QKM(C, i, acc_) C = __builtin_amdgcn_mfma_f32_32x32x16_bf16(kf[i], qrg[(i) >> 1], acc_, 0, 0, 0)
#endif
#if PV_F8
#define STEP(C0, C1, P0, P1, t, GK, GV, GL) do { SBAR(); \
    const lds_cptr vp_ = vp0 + sl_prev; \
    VRD(0); SBAR(); GAPA8(QKM(C0, 0, negm), p8lo[0] = PK4(P0, 0), p8lo); \
    VRD(4); SBAR(); GAPA8(QKM(C1, 1, negm), p8lo[1] = PK4(P0, 4), p8lo); \
    VRD(1); SBAR(); GAPA8((void)0, p8lo[2] = PK4(P0, 8), p8lo); \
    VRD(5); SBAR(); GAPA8((void)0, p8lo[3] = PK4(P0, 12), p8lo); \
    VRD(2); SBAR(); GAPA8((void)0, p8hi[0] = PK4(P1, 0), p8hi); \
    VRD(6); SBAR(); GAPA8((void)0, p8hi[1] = PK4(P1, 4), p8hi); \
    VRD(3); SBAR(); GAPA8((void)0, p8hi[2] = PK4(P1, 8), p8hi); \
    VRD(7); SBAR(); GAPA8((void)0, p8hi[3] = PK4(P1, 12), p8hi); \
    if (GK) { DMA_K((t) + 3, sl_cur); } if (GV) { DMA_V((t) + 1, sl_next); } \
    CMASK(C0, C1, t); \
    { float a = MX3(C0[0], C0[1], C1[0]), b = MX3(C0[2], C0[3], C1[1]); a = MX3(a, C1[2], C1[3]); \
      _Pragma("unroll") for (int r = 4; r < 16; r += 4) { a = MX3(a, C0[r], C0[r + 1]); b = MX3(b, C0[r + 2], C0[r + 3]); a = MX3(a, C1[r], C1[r + 1]); b = MX3(b, C1[r + 2], C1[r + 3]); } \
      float rm = __builtin_fmaxf(a, b); { auto rr = __builtin_amdgcn_permlane32_swap(__float_as_uint(rm), __float_as_uint(rm), false, false); rm = __builtin_fmaxf(__uint_as_float(rr[0]), __uint_as_float(rr[1])); } \
      resc = false; \
      if (__builtin_expect(__any(rm > (float)THRL), 0)) { const float dl = __builtin_fmaxf(rm, 0.f); mhat += dl; \
        _Pragma("unroll") for (int r = 0; r < 16; ++r) { C0[r] -= dl; C1[r] -= dl; } \
        _Pragma("unroll") for (int r = 0; r < 16; ++r) negm[r] = -mhat; asm volatile("" : "+v"(negm)); \
        const float f = __builtin_amdgcn_exp2f(-dl); if (hi == 0) wsf[r32] = f; resc = true; } } \
    SBAR(); \
    GAPB(PVM(0), C0, 0); \
    GAPB(lacc = LSUM(), C0, 4); \
    KRD(GL, 0); GAPB((void)0, C0, 8); \
    KRD(GL, 1); GAPB((void)0, C0, 12); \
    GAPB(PVM(1), C1, 0); \
    GAPB((void)0, C1, 4); \
    GAPB((void)0, C1, 8); \
    GAPB((void)0, C1, 12); \
    } while (0)
#else
#define STEP(C0, C1, P0, P1, t, GK, GV, GL) do { SBAR(); \
    const lds_cptr vp_ = vp0 + sl_prev; \
    VRD(0); SBAR(); \
    GAPA(QKM(C0, 0, negm), P0[2], P0[3], P0[4], P0[5],     pw0[0] = PKW(P0, 0), pw0[1] = PKW(P0, 2), pw0); \
    VRD(4); SBAR(); GAPA(QKM(C1, 1, negm), P0[6], P0[7], P0[8], P0[9],     pw0[2] = PKW(P0, 4), pw0[3] = PKW(P0, 6), pw0); \
    VRD(1); SBAR(); GAPA(QKM(C0, 2, C0),   P0[10], P0[11], P0[12], P0[13], pw1[0] = PKW(P0, 8), pw1[1] = PKW(P0, 10), pw1); \
    VRD(5); SBAR(); GAPA(QKM(C1, 3, C1),   P0[14], P0[15], P1[0], P1[1],   pw1[2] = PKW(P0, 12), pw1[3] = PKW(P0, 14), pw1); \
    VRD(2); SBAR(); GAPA(QKM(C0, 4, C0),   P1[2], P1[3], P1[4], P1[5],     pw2[0] = PKW(P1, 0), pw2[1] = PKW(P1, 2), pw2); \
    VRD(6); SBAR(); GAPA(QKM(C1, 5, C1),   P1[6], P1[7], P1[8], P1[9],     pw2[2] = PKW(P1, 4), pw2[3] = PKW(P1, 6), pw2); \
    VRD(3); SBAR(); GAPA(QKM(C0, 6, C0),   P1[10], P1[11], P1[12], P1[13], pw3[0] = PKW(P1, 8), pw3[1] = PKW(P1, 10), pw3); \
    VRD(7); SBAR(); GAPA(QKM(C1, 7, C1),   P1[14], P1[15], 0.f, 0.f,       pw3[2] = PKW(P1, 12), pw3[3] = PKW(P1, 14), pw3); \
    if (GK) { DMA_K((t) + 3, sl_cur); } if (GV) { DMA_V((t) + 1, sl_next); } \
    CMASK(C0, C1, t); \
    { float a = MX3(C0[0], C0[1], C1[0]), b = MX3(C0[2], C0[3], C1[1]); a = MX3(a, C1[2], C1[3]); \
      _Pragma("unroll") for (int r = 4; r < 16; r += 4) { a = MX3(a, C0[r], C0[r + 1]); b = MX3(b, C0[r + 2], C0[r + 3]); a = MX3(a, C1[r], C1[r + 1]); b = MX3(b, C1[r + 2], C1[r + 3]); } \
      float rm = __builtin_fmaxf(a, b); { auto rr = __builtin_amdgcn_permlane32_swap(__float_as_uint(rm), __float_as_uint(rm), false, false); rm = __builtin_fmaxf(__uint_as_float(rr[0]), __uint_as_float(rr[1])); } \
      resc = false; \
      if (__builtin_expect(__any(rm > (float)THRL), 0)) { const float dl = __builtin_fmaxf(rm, 0.f); mhat += dl; \
        _Pragma("unroll") for (int r = 0; r < 16; ++r) { C0[r] -= dl; C1[r] -= dl; } \
        _Pragma("unroll") for (int r = 0; r < 16; ++r) negm[r] = -mhat; asm volatile("" : "+v"(negm)); \
        const float f = __builtin_amdgcn_exp2f(-dl); if (hi == 0) wsf[r32] = f; resc = true; } } \
    SBAR(); \
    GAPB(o[0] = __builtin_amdgcn_mfma_f32_32x32x16_bf16(PAF(0), VFR(0), o[0], 0, 0, 0), C0, 0); \
    GAPB(o[1] = __builtin_amdgcn_mfma_f32_32x32x16_bf16(PAF(0), VFR(4), o[1], 0, 0, 0), C0, 4); \
    lacc = __builtin_amdgcn_mfma_f32_16x16x32_bf16(PAF(0), ones, lacc, 0, 0, 0); \
    KRD(GL, 0); GAPB(o[0] = __builtin_amdgcn_mfma_f32_32x32x16_bf16(PAF(1), VFR(1), o[0], 0, 0, 0), C0, 8); \
    KRD(GL, 1); GAPB(o[1] = __builtin_amdgcn_mfma_f32_32x32x16_bf16(PAF(1), VFR(5), o[1], 0, 0, 0), C0, 12); \
    lacc = __builtin_amdgcn_mfma_f32_16x16x32_bf16(PAF(1), ones, lacc, 0, 0, 0); \
    KRD(GL, 2); GAPB(o[0] = __builtin_amdgcn_mfma_f32_32x32x16_bf16(PAF(2), VFR(2), o[0], 0, 0, 0), C1, 0); \
    KRD(GL, 3); GAPB(o[1] = __builtin_amdgcn_mfma_f32_32x32x16_bf16(PAF(2), VFR(6), o[1], 0, 0, 0), C1, 4); \
    lacc = __builtin_amdgcn_mfma_f32_16x16x32_bf16(PAF(2), ones, lacc, 0, 0, 0); \
    GAPB(o[0] = __builtin_amdgcn_mfma_f32_32x32x16_bf16(PAF(3), VFR(3), o[0], 0, 0, 0), C1, 8); \
    GAPB(o[1] = __builtin_amdgcn_mfma_f32_32x32x16_bf16(PAF(3), VFR(7), o[1], 0, 0, 0), C1, 12); \
    lacc = __builtin_amdgcn_mfma_f32_16x16x32_bf16(PAF(3), ones, lacc, 0, 0, 0); \
    } while (0)
#endif
  int t = 1;
  for (; t + 5 < NT; t += 2) {
    STEP(pB0, pB1, pA0, pA1, t, true, true, true);     WAIT_STEADY(); RESC(); ROT();
    STEP(pA0, pA1, pB0, pB1, t + 1, true, true, true); WAIT_STEADY(); RESC(); ROT();
  }
#if PV_F8 && DMA_ROLES
#define ENDW(tt) do { if ((tt) + 3 < NT) { WAIT_BAR(1); } else { WAIT_BAR(0); } } while (0)
#else
#define ENDW(tt) do { if ((tt) + 3 < NT) { WAIT_BAR(2); } else if ((tt) + 2 < NT) { WAIT_BAR(1); } else { WAIT_BAR(0); } } while (0)
#endif
  for (; t + 1 < NT; t += 2) {
    STEP(pB0, pB1, pA0, pA1, t, (t + 3 < NT), (t + 1 < NT), (t + 1 < NT));       ENDW(t);     RESC(); ROT();
    STEP(pA0, pA1, pB0, pB1, t + 1, (t + 4 < NT), (t + 2 < NT), (t + 2 < NT));   ENDW(t + 1); RESC(); ROT();
  }
  STEP(pB0, pB1, pA0, pA1, NT - 1, false, false, false); RESC();
#if PV_F8
  { p8lo = (u32x4){PK4(pB0, 0), PK4(pB0, 4), PK4(pB0, 8), PK4(pB0, 12)}; p8hi = (u32x4){PK4(pB1, 0), PK4(pB1, 4), PK4(pB1, 8), PK4(pB1, 12)};
    SBAR(); const lds_cptr vp_ = vp0 + sl_cur;
    VRD(0); VRD(1); VRD(2); VRD(3); VRD(4); VRD(5); VRD(6); VRD(7);
    PVM(0); PVM(1); lacc = LSUM(); }
#else
  {
    pw0 = (u32x4){PKW(pB0, 0), PKW(pB0, 2), PKW(pB0, 4), PKW(pB0, 6)}; pw1 = (u32x4){PKW(pB0, 8), PKW(pB0, 10), PKW(pB0, 12), PKW(pB0, 14)}; pw2 = (u32x4){PKW(pB1, 0), PKW(pB1, 2), PKW(pB1, 4), PKW(pB1, 6)}; pw3 = (u32x4){PKW(pB1, 8), PKW(pB1, 10), PKW(pB1, 12), PKW(pB1, 14)};
    SBAR(); pv(o, vb0 + sl_cur, PAF(0), PAF(1), PAF(2), PAF(3));
    lacc = __builtin_amdgcn_mfma_f32_16x16x32_bf16(PAF(0), ones, lacc, 0, 0, 0); lacc = __builtin_amdgcn_mfma_f32_16x16x32_bf16(PAF(1), ones, lacc, 0, 0, 0);
    lacc = __builtin_amdgcn_mfma_f32_16x16x32_bf16(PAF(2), ones, lacc, 0, 0, 0); lacc = __builtin_amdgcn_mfma_f32_16x16x32_bf16(PAF(3), ones, lacc, 0, 0, 0); }
#endif
#undef PKW
#undef PAF
#undef VFR
#undef PIN
#undef MX3
#undef GAPA
#undef GAPB
#undef EX
#undef VRD
#undef KRD
#undef STEP
#undef ENDW
  if ((lane & 7) == 0) { const int lr0_ = LROW0();
#pragma unroll
    for (int r = 0; r < 4; ++r) wsf[32 + lr0_ + r] = lacc[r]; }
#undef LROW0
  asm volatile("s_waitcnt lgkmcnt(0)" ::: "memory");
  float rli[16];
#pragma unroll
  for (int r = 0; r < 16; ++r) rli[r] = __builtin_amdgcn_rcpf(wsf[32 + crow(r, hi)]);
  bf16* Ow = Ow0 + (long)(wid * QBLK) * OP;
  { bf16* stg = (bf16*)(shm + LDS_OST) + wid * 2048;
#pragma unroll
    for (int r = 0; r < 16; ++r) { const int orow = crow(r, hi);
#pragma unroll
      for (int d0 = 0; d0 < 2; ++d0) stg[orow * 64 + d0 * 32 + r32] = __float2bfloat16(o[d0][r] * rli[r]); }
    asm volatile("s_waitcnt lgkmcnt(0)" ::: "memory");
#pragma unroll
    for (int i = 0; i < 4; ++i) { const int row = i * 8 + (lane >> 3), ch = lane & 7; const u32x4 v = *(const u32x4*)(stg + row * 64 + ch * 8); *(u32x4*)(Ow + (long)row * OP + ch * 8) = v;
      float q = (bflo(v.x) * bflo(v.x) + bfhi(v.x) * bfhi(v.x)) + (bflo(v.y) * bflo(v.y) + bfhi(v.y) * bfhi(v.y)) + (bflo(v.z) * bflo(v.z) + bfhi(v.z) * bfhi(v.z)) + (bflo(v.w) * bflo(v.w) + bfhi(v.w) * bfhi(v.w));
      q += shx(q, 1, lane); q += shx(q, 2, lane); q += shx(q, 4, lane); if (ch == 0) st0[(long)(wid * QBLK + row) * 80] = q; } }
  asm volatile("s_waitcnt lgkmcnt(0)\n\ts_barrier" ::: "memory");
#undef DMA_K
#undef DMA_V
#undef TROW
#undef CMASK
#undef START
#undef RESC
#undef ROT
}
#undef SBAR
#undef WAIT_BAR
}

#define XB_TMO      128
#define XB_XCNT(j)  (256  + 64 * (j))
#define XB_XSUB(j)  (1280 + 64 * (j))
#define XB_XGEN(j)  (2304 + 64 * (j))
#define XB_TOP      3328
#define XB_TOPGEN   3392
#define XCD_BAR_WORDS 3456
#define XB_SPIN_CAP (1u << 18)
__device__ __forceinline__ unsigned xb_ld(unsigned* p)              { return __hip_atomic_load((GAS unsigned*)p, __ATOMIC_RELAXED, __HIP_MEMORY_SCOPE_AGENT); }
__device__ __forceinline__ unsigned xb_add(unsigned* p, unsigned v) { return __hip_atomic_fetch_add((GAS unsigned*)p, v, __ATOMIC_RELAXED, __HIP_MEMORY_SCOPE_AGENT); }
__device__ __forceinline__ unsigned xb_xcc_id() { return (unsigned)__builtin_amdgcn_s_getreg((3 << 11) | 20) & 0xFu; }
#define XB_SPIN(cond, bar) do { unsigned _sp = 0; while (cond) { __builtin_amdgcn_s_sleep(1); \
    if ((++_sp & 255u) == 0u) { if (xb_ld(&(bar)[XB_TMO])) break; if (_sp > XB_SPIN_CAP) { (void)xb_add(&(bar)[XB_TMO], 1u); break; } } } } while (0)
struct XcdBarrier { unsigned* bar; unsigned x; volatile LAS unsigned* st; };
__device__ __forceinline__ XcdBarrier xcd_barrier_post(unsigned* bar, volatile LAS unsigned* st) {
    XcdBarrier b; b.bar = bar; b.x = xb_xcc_id(); b.st = st;
    if (threadIdx.x == 0) (void)xb_add(&bar[XB_XCNT(b.x)], 1u);
    return b;
}
__device__ __forceinline__ void xcd_barrier_complete(unsigned* bar, unsigned x, unsigned& nloc, unsigned& nx) {
    const unsigned G = gridDim.x * gridDim.y * gridDim.z;
    unsigned sum, cnt, mine, sp = 0u;
    for (;;) {
        sum = 0u; cnt = 0u; mine = 0u;
#pragma nounroll
        for (unsigned j = 0; j < 16; ++j) { const unsigned c = xb_ld(&bar[XB_XCNT(j)]); sum += c; cnt += (c > 0u) ? 1u : 0u; mine = (j == x) ? c : mine; }
        if (sum == G) break;
        __builtin_amdgcn_s_sleep(1);
        if ((++sp & 255u) == 0u) { if (xb_ld(&bar[XB_TMO])) break; if (sp > XB_SPIN_CAP) { (void)xb_add(&bar[XB_TMO], 1u); break; } }
    }
    nloc = mine > 0u ? mine : 1u; nx = cnt > 0u ? cnt : 1u;
}
__device__ __forceinline__ void xcd_barrier(const XcdBarrier& b) {
    asm volatile("s_waitcnt vmcnt(0)" ::: "memory");
    __syncthreads();
    if (threadIdx.x == 0) {
        unsigned* bar = b.bar;
        __builtin_amdgcn_s_waitcnt(0);
        unsigned nloc = b.st[0], nx = b.st[1];
        if (nloc == 0u) { xcd_barrier_complete(bar, b.x, nloc, nx); b.st[0] = nloc; b.st[1] = nx; }
        const unsigned old = xb_add(&bar[XB_XSUB(b.x)], 1u);
        const unsigned gen = old / nloc;
        if (old + 1u == (gen + 1u) * nloc) {
            __builtin_amdgcn_fence(__ATOMIC_RELEASE, "agent");
            asm volatile("s_waitcnt vmcnt(0)" ::: "memory");
            const unsigned og = xb_add(&bar[XB_TOP], 1u);
            const unsigned tg = og / nx;
            if (og + 1u == (tg + 1u) * nx) xb_add(&bar[XB_TOPGEN], 1u);
            else XB_SPIN(xb_ld(&bar[XB_TOPGEN]) == tg, bar);
            __builtin_amdgcn_fence(__ATOMIC_ACQUIRE, "agent");
            xb_add(&bar[XB_XGEN(b.x)], 1u);
            asm volatile("s_waitcnt vmcnt(0)" ::: "memory");
        } else {
            XB_SPIN(xb_ld(&bar[XB_XGEN(b.x)]) == gen, bar);
            __builtin_amdgcn_fence(__ATOMIC_ACQUIRE, "agent");
            asm volatile("s_waitcnt vmcnt(0)" ::: "memory");
        }
    }
    __syncthreads();
}

struct Args {
    const float *x, *c, *ctx, *c_ctx, *w_ada, *b_ada, *g_mix, *g_ffn, *w_in, *g_q, *g_k, *rel_bias, *g_out_a, *g_out_b, *g_out_c, *w_out, *w_router, *w_gate, *w_up, *w_down, *g_final;
    float* out; unsigned char* ws; int ph_lo, ph_hi;
};
constexpr int NWAVES = 8;
constexpr int PH_PER_LAYER = 9;
constexpr int NPHASE = 1 + 2 * PH_PER_LAYER;

__device__ __forceinline__ void tr_item8(const float* W, int N, int k0, int n0, unsigned char* WT, int K, int out_row0, int out_row1  , float scale, LAS float* scr, int lane) {
    f32x4 v[16];
    const int lr = lane >> 4, lc4 = 4 * (lane & 15);
#pragma unroll
    for (int i = 0; i < 16; ++i) v[i] = *(const f32x4*)(W + (size_t)(k0 + 4 * i + lr) * N + n0 + lc4);
#pragma unroll
    for (int i = 0; i < 16; ++i) { LAS float* d = scr + (4 * i + lr) * 65 + lc4;
        d[0] = v[i].x * scale; d[1] = v[i].y * scale; d[2] = v[i].z * scale; d[3] = v[i].w * scale; }
    LDS_WAIT(); asm volatile("" ::: "memory");
    const int c = lane & 7;
#pragma unroll
    for (int j = 0; j < 8; ++j) { const int n = (lane >> 3) + 8 * j; const LAS float* sp = scr + (8 * c) * 65 + n;
        u32x2 o; o.x = pk4_fp8(sp[0 * 65], sp[1 * 65], sp[2 * 65], sp[3 * 65]); o.y = pk4_fp8(sp[4 * 65], sp[5 * 65], sp[6 * 65], sp[7 * 65]);
        *(u32x2*)(WT + (size_t)((j < 4) ? out_row0 + n : out_row1 + n - 32) * K + k0 + 8 * c) = o; }
    LDS_WAIT(); asm volatile("" ::: "memory");
}
__device__ __forceinline__ void tr_item(const float* W, int N, int k0, int n0, bf16_t* WT, int K, int out_row0, int out_row1  , float scale, const float* kscale, LAS float* scr, int lane) {
    f32x4 v[16];
    const int lr = lane >> 4, lc4 = 4 * (lane & 15);
#pragma unroll
    for (int i = 0; i < 16; ++i) v[i] = *(const f32x4*)(W + (size_t)(k0 + 4 * i + lr) * N + n0 + lc4);
#pragma unroll
    for (int i = 0; i < 16; ++i) { float sc = scale; if (kscale) sc *= kscale[k0 + 4 * i + lr]; LAS float* d = scr + (4 * i + lr) * 65 + lc4;
        d[0] = v[i].x * sc; d[1] = v[i].y * sc; d[2] = v[i].z * sc; d[3] = v[i].w * sc; }
    LDS_WAIT(); asm volatile("" ::: "memory");
    const int c = lane & 7;
#pragma unroll
    for (int j = 0; j < 8; ++j) { const int n = (lane >> 3) + 8 * j; const LAS float* sp = scr + (8 * c) * 65 + n;
        u32x4 o; o.x = pg8::cvt_pk_bf16(sp[0 * 65], sp[1 * 65]); o.y = pg8::cvt_pk_bf16(sp[2 * 65], sp[3 * 65]); o.z = pg8::cvt_pk_bf16(sp[4 * 65], sp[5 * 65]); o.w = pg8::cvt_pk_bf16(sp[6 * 65], sp[7 * 65]);
        *(u32x4*)(WT + (size_t)((j < 4) ? out_row0 + n : out_row1 + n - 32) * K + k0 + 8 * c) = o; }
    LDS_WAIT(); asm volatile("" ::: "memory");
}

__device__ __forceinline__ void norm_mod_row(f32x4 (&v)[4], const float* g, const float* shift, const float* scale, int lane) {
    float s = 0.f;
#pragma unroll
    for (int j = 0; j < 4; ++j) s += (v[j].x * v[j].x + v[j].y * v[j].y) + (v[j].z * v[j].z + v[j].w * v[j].w);
    const float r = 1.0f / sqrtf(wave_sum(s, lane) * (1.f / DM) + EPS);
#pragma unroll
    for (int j = 0; j < 4; ++j) { const int c = 4 * lane + 256 * j; const f32x4 gv = *(const f32x4*)(g + c);
        f32x4 y = v[j] * r * gv;
        if (shift) { const f32x4 sh = *(const f32x4*)(shift + c), sc = *(const f32x4*)(scale + c); y = y * (sc + 1.0f) + sh; }
        v[j] = y; }
}
__device__ __forceinline__ void store_row_fp8(unsigned char* orow, const f32x4 (&v)[4], int lane) {
#pragma unroll
    for (int j = 0; j < 4; ++j) *(unsigned*)(orow + 4 * lane + 256 * j) = pk4_fp8(v[j].x, v[j].y, v[j].z, v[j].w);
}
__device__ __forceinline__ void store_row_bf16(bf16_t* orow, const f32x4 (&v)[4], int lane) {
#pragma unroll
    for (int j = 0; j < 4; ++j) { u32x2 w; w.x = pk2(v[j].x, v[j].y); w.y = pk2(v[j].z, v[j].w); *(u32x2*)(orow + 4 * lane + 256 * j) = w; }
}

constexpr int FT_M1 = 69632, FT_W3 = FT_M1 + 128 * 272, FT_P = 136;
__device__ __forceinline__ void fourier_tables_to_lds(LAS unsigned char* lds, const bf16_t* M1, const bf16_t* W3) {
    const int tid = tid_fresh();
    for (int i = tid; i < (128 + 64) * 16; i += 512) { const int row = i >> 4, c = i & 15; const u32x4 v = *(const u32x4*)((row < 128 ? M1 + row * 128 : W3 + (row - 128) * 128) + 8 * c);
        *(LAS u32x4*)(lds + FT_M1 + row * 272 + 16 * c) = v; }
    __syncthreads();
}
__device__ __forceinline__ void fourier_unit(LAS unsigned char* lds, const bf16_t* QKV, bf16_t* OCAT, const float* TW, float* ST, int b, int g, int lc) {
    const int tid = tid_fresh(), lane = tid & 63, wid = __builtin_amdgcn_readfirstlane(tid >> 6), r32 = lane & 31, h = lane >> 5;
    LAS bf16_t* XT = (LAS bf16_t*)lds;
    constexpr int XP = 136;
#pragma unroll 4
    for (int it = 0; it < 16; ++it) { const int combo = it * 8 + wid, ri = combo >> 6, n2 = combo & 63, n1 = lane, token = 64 * n1 + n2;
        const u32x2 v = *(const u32x2*)(QKV + O_VRI + (size_t)(b * TT + token) * 512 + ri * 256 + g * 64 + 4 * lc);
        const int col = ri * 64 + n1;
        XT[(0 * 64 + n2) * XP + col] = (bf16_t)(v.x & 0xffffu); XT[(1 * 64 + n2) * XP + col] = (bf16_t)(v.x >> 16);
        XT[(2 * 64 + n2) * XP + col] = (bf16_t)(v.y & 0xffffu); XT[(3 * 64 + n2) * XP + col] = (bf16_t)(v.y >> 16); }
    __syncthreads();
    f32x16 acc[4];
#pragma unroll
    for (int ct = 0; ct < 4; ++ct) acc[ct] = f32x16{};
#pragma unroll
    for (int s = 0; s < 8; ++s) {
        const bf16x8 a = *(const LAS bf16x8*)(XT + (32 * wid + r32) * XP + 16 * s + 8 * h);
#pragma unroll
        for (int ct = 0; ct < 4; ++ct) { const bf16x8 bb = *(const LAS bf16x8*)(lds + FT_M1 + ((32 * ct + r32) * FT_P + 16 * s + 8 * h) * 2);
            acc[ct] = __builtin_amdgcn_mfma_f32_32x32x16_bf16(a, bb, acc[ct], 0, 0, 0); } }
    __syncthreads();
    {
        const int l = wid >> 1;
#pragma unroll
        for (int q = 0; q < 2; ++q) { const int k1 = 32 * q + r32;
#pragma unroll
            for (int rg = 0; rg < 4; ++rg) { const int n2_0 = 32 * (wid & 1) + 8 * rg + 4 * h;
                const f32x4 t0 = *(const f32x4*)(TW + ((size_t)k1 * 64 + n2_0) * 2), t1 = *(const f32x4*)(TW + ((size_t)k1 * 64 + n2_0) * 2 + 4);
                const float cs[4] = {t0.x, t0.z, t1.x, t1.z}, sn[4] = {t0.y, t0.w, t1.y, t1.w};
                float pr[4], pi[4];
#pragma unroll
                for (int j = 0; j < 4; ++j) { const float gr = acc[q][4 * rg + j], gi = acc[q + 2][4 * rg + j]; pr[j] = gr * cs[j] + gi * sn[j]; pi[j] = gi * cs[j] - gr * sn[j]; }
                u32x2 wr_, wi_; wr_.x = pk2(pr[0], pr[1]); wr_.y = pk2(pr[2], pr[3]); wi_.x = pk2(pi[0], pi[1]); wi_.y = pk2(pi[2], pi[3]);
                const int sw = (k1 & 7) << 3;
                *(LAS u32x2*)(XT + (4 * k1 + l) * XP + ((n2_0 & ~7) ^ sw) + (n2_0 & 7)) = wr_; *(LAS u32x2*)(XT + (4 * k1 + l) * XP + (((64 + n2_0) & ~7) ^ sw) + (n2_0 & 7)) = wi_; } }
    }
    __syncthreads();
    f32x16 o[2]; o[0] = f32x16{}; o[1] = f32x16{};
    const int swr = (((32 * wid + r32) >> 2) & 7) << 3;
#pragma unroll
    for (int s = 0; s < 8; ++s) {
        const bf16x8 a = *(const LAS bf16x8*)(XT + (32 * wid + r32) * XP + ((16 * s + 8 * h) ^ swr));
#pragma unroll
        for (int ct = 0; ct < 2; ++ct) { const bf16x8 bb = *(const LAS bf16x8*)(lds + FT_W3 + ((32 * ct + r32) * FT_P + 16 * s + 8 * h) * 2);
            o[ct] = __builtin_amdgcn_mfma_f32_32x32x16_bf16(a, bb, o[ct], 0, 0, 0); } }
#pragma unroll
    for (int ct = 0; ct < 2; ++ct) { const int k2 = 32 * ct + r32;
#pragma unroll
        for (int rg = 0; rg < 4; ++rg) { const int k1 = 8 * wid + 2 * rg + h, token = k1 + 64 * k2;
            u32x2 w; w.x = pk2(o[ct][4 * rg + 0], o[ct][4 * rg + 1]); w.y = pk2(o[ct][4 * rg + 2], o[ct][4 * rg + 3]);
            *(u32x2*)(OCAT + (size_t)(b * TT + token) * DM + 512 + g * 64 + 4 * lc) = w;
            ST[(size_t)(b * TT + token) * 80 + 12 + g * 16 + lc] = (bflo(w.x) * bflo(w.x) + bfhi(w.x) * bfhi(w.x)) + (bflo(w.y) * bflo(w.y) + bfhi(w.y) * bfhi(w.y)); } }
    __syncthreads();
}
__device__ __forceinline__ void fourier_unit2(LAS unsigned char* lds, const bf16_t* QKV, bf16_t* OCAT, const float* TW, float* ST, int b, int g, int lc2) {
    const int tid = tid_fresh(), lane = tid & 63, wid = __builtin_amdgcn_readfirstlane(tid >> 6), r32 = lane & 31, h = lane >> 5;
    LAS bf16_t* XT = (LAS bf16_t*)lds;
    constexpr int XP = 136;
    u32x2 vhi[16]; u32x2 res0[2][4];
#pragma unroll
    for (int it = 0; it < 16; ++it) { const int combo = it * 8 + wid, ri = combo >> 6, n2 = combo & 63, n1 = lane, token = 64 * n1 + n2;
        const u32x4 v4 = *(const u32x4*)(QKV + O_VRI + (size_t)(b * TT + token) * 512 + ri * 256 + g * 64 + 8 * lc2);
        const u32x2 v = {v4.x, v4.y}; vhi[it] = (u32x2){v4.z, v4.w};
        const int col = ri * 64 + n1;
        XT[(0 * 64 + n2) * XP + col] = (bf16_t)(v.x & 0xffffu); XT[(1 * 64 + n2) * XP + col] = (bf16_t)(v.x >> 16);
        XT[(2 * 64 + n2) * XP + col] = (bf16_t)(v.y & 0xffffu); XT[(3 * 64 + n2) * XP + col] = (bf16_t)(v.y >> 16); }
#pragma unroll
    for (int pass = 0; pass < 2; ++pass) {
    if (pass == 1) {
#pragma unroll
        for (int it = 0; it < 16; ++it) { const int combo = it * 8 + wid, ri = combo >> 6, n2 = combo & 63, n1 = lane; const u32x2 v = vhi[it];
            const int col = ri * 64 + n1;
            XT[(0 * 64 + n2) * XP + col] = (bf16_t)(v.x & 0xffffu); XT[(1 * 64 + n2) * XP + col] = (bf16_t)(v.x >> 16);
            XT[(2 * 64 + n2) * XP + col] = (bf16_t)(v.y & 0xffffu); XT[(3 * 64 + n2) * XP + col] = (bf16_t)(v.y >> 16); } }
    __syncthreads();
    f32x16 acc[4];
#pragma unroll
    for (int ct = 0; ct < 4; ++ct) acc[ct] = f32x16{};
#pragma unroll
    for (int s = 0; s < 8; ++s) {
        const bf16x8 a = *(const LAS bf16x8*)(XT + (32 * wid + r32) * XP + 16 * s + 8 * h);
#pragma unroll
        for (int ct = 0; ct < 4; ++ct) { const bf16x8 bb = *(const LAS bf16x8*)(lds + FT_M1 + ((32 * ct + r32) * FT_P + 16 * s + 8 * h) * 2);
            acc[ct] = __builtin_amdgcn_mfma_f32_32x32x16_bf16(a, bb, acc[ct], 0, 0, 0); } }
    __syncthreads();
    {
        const int l = wid >> 1;
#pragma unroll
        for (int q = 0; q < 2; ++q) { const int k1 = 32 * q + r32;
#pragma unroll
            for (int rg = 0; rg < 4; ++rg) { const int n2_0 = 32 * (wid & 1) + 8 * rg + 4 * h;
                const f32x4 t0 = *(const f32x4*)(TW + ((size_t)k1 * 64 + n2_0) * 2), t1 = *(const f32x4*)(TW + ((size_t)k1 * 64 + n2_0) * 2 + 4);
                const float cs[4] = {t0.x, t0.z, t1.x, t1.z}, sn[4] = {t0.y, t0.w, t1.y, t1.w};
                float pr[4], pi[4];
#pragma unroll
                for (int j = 0; j < 4; ++j) { const float gr = acc[q][4 * rg + j], gi = acc[q + 2][4 * rg + j]; pr[j] = gr * cs[j] + gi * sn[j]; pi[j] = gi * cs[j] - gr * sn[j]; }
                u32x2 wr_, wi_; wr_.x = pk2(pr[0], pr[1]); wr_.y = pk2(pr[2], pr[3]); wi_.x = pk2(pi[0], pi[1]); wi_.y = pk2(pi[2], pi[3]);
                const int sw = (k1 & 7) << 3;
                *(LAS u32x2*)(XT + (4 * k1 + l) * XP + ((n2_0 & ~7) ^ sw) + (n2_0 & 7)) = wr_; *(LAS u32x2*)(XT + (4 * k1 + l) * XP + (((64 + n2_0) & ~7) ^ sw) + (n2_0 & 7)) = wi_; } }
    }
    __syncthreads();
    f32x16 o[2]; o[0] = f32x16{}; o[1] = f32x16{};
    const int swr = (((32 * wid + r32) >> 2) & 7) << 3;
#pragma unroll
    for (int s = 0; s < 8; ++s) {
        const bf16x8 a = *(const LAS bf16x8*)(XT + (32 * wid + r32) * XP + ((16 * s + 8 * h) ^ swr));
#pragma unroll
        for (int ct = 0; ct < 2; ++ct) { const bf16x8 bb = *(const LAS bf16x8*)(lds + FT_W3 + ((32 * ct + r32) * FT_P + 16 * s + 8 * h) * 2);
            o[ct] = __builtin_amdgcn_mfma_f32_32x32x16_bf16(a, bb, o[ct], 0, 0, 0); } }
#pragma unroll
    for (int ct = 0; ct < 2; ++ct) { const int k2 = 32 * ct + r32;
#pragma unroll
        for (int rg = 0; rg < 4; ++rg) { const int k1 = 8 * wid + 2 * rg + h, token = k1 + 64 * k2;
            u32x2 w; w.x = pk2(o[ct][4 * rg + 0], o[ct][4 * rg + 1]); w.y = pk2(o[ct][4 * rg + 2], o[ct][4 * rg + 3]);
            ST[(size_t)(b * TT + token) * 80 + 12 + g * 16 + 2 * lc2 + pass] = (bflo(w.x) * bflo(w.x) + bfhi(w.x) * bfhi(w.x)) + (bflo(w.y) * bflo(w.y) + bfhi(w.y) * bfhi(w.y));
            if (pass == 0) res0[ct][rg] = w;
            else { u32x4 w4; w4.x = res0[ct][rg].x; w4.y = res0[ct][rg].y; w4.z = w.x; w4.w = w.y; *(u32x4*)(OCAT + (size_t)(b * TT + token) * DM + 512 + g * 64 + 8 * lc2) = w4; } } }
    __syncthreads();
    }
}

__device__ __forceinline__ void fourier_ctx_unit(LAS unsigned char* lds, const bf16_t* QKV, bf16_t* OCAT, const bf16_t* CSC, float* ST, int b, int g) {
    const int tid = tid_fresh(), lane = tid & 63, wid = __builtin_amdgcn_readfirstlane(tid >> 6), r32 = lane & 31, h = lane >> 5;
    LAS bf16_t* VT = (LAS bf16_t*)lds; constexpr int VP = 520;
#pragma unroll
    for (int it = 0; it < 8; ++it) { const int p = it * 512 + tid, n = p & 255, c8 = (p >> 8) & 7, ri = p >> 11;
        const u32x4 v = *(const u32x4*)(QKV + O_VRI + (size_t)(b * TT + SEQ + n) * 512 + ri * 256 + g * 64 + 8 * c8);
        LAS bf16_t* d = VT + (8 * c8) * VP + ri * 256 + n;
        d[0 * VP] = (bf16_t)(v.x & 0xffffu); d[1 * VP] = (bf16_t)(v.x >> 16); d[2 * VP] = (bf16_t)(v.y & 0xffffu); d[3 * VP] = (bf16_t)(v.y >> 16);
        d[4 * VP] = (bf16_t)(v.z & 0xffffu); d[5 * VP] = (bf16_t)(v.z >> 16); d[6 * VP] = (bf16_t)(v.w & 0xffffu); d[7 * VP] = (bf16_t)(v.w >> 16); }
    __syncthreads();
    f32x16 acc[2]; acc[0] = f32x16{}; acc[1] = f32x16{};
    const bf16_t* bp = CSC + (size_t)(32 * wid + r32) * 512 + 8 * h;
#pragma unroll 8
    for (int s = 0; s < 32; ++s) { const bf16x8 bb = *(const bf16x8*)(bp + 16 * s);
#pragma unroll
        for (int rt = 0; rt < 2; ++rt) { const bf16x8 a = *(const LAS bf16x8*)(VT + (32 * rt + r32) * VP + 16 * s + 8 * h); acc[rt] = __builtin_amdgcn_mfma_f32_32x32x16_bf16(a, bb, acc[rt], 0, 0, 0); } }
    const int k = 32 * wid + r32;
#pragma unroll
    for (int rt = 0; rt < 2; ++rt)
#pragma unroll
        for (int rg = 0; rg < 4; ++rg) { u32x2 w; w.x = pk2(acc[rt][4 * rg + 0], acc[rt][4 * rg + 1]); w.y = pk2(acc[rt][4 * rg + 2], acc[rt][4 * rg + 3]);
            *(u32x2*)(OCAT + (size_t)(b * TT + SEQ + k) * DM + 512 + g * 64 + 32 * rt + 8 * rg + 4 * h) = w;
            ST[(size_t)(b * TT + SEQ + k) * 80 + 12 + g * 16 + rt * 8 + rg * 2 + h] = (bflo(w.x) * bflo(w.x) + bfhi(w.x) * bfhi(w.x)) + (bflo(w.y) * bflo(w.y) + bfhi(w.y) * bfhi(w.y)); }
    __syncthreads();
}

typedef const __attribute__((address_space(4))) Args* KArgs;
#define PHASE_ENV \
    KArgs ka = (KArgs)__builtin_amdgcn_kernarg_segment_ptr(); asm volatile("" : "+s"(ka)); \
    int G = G0, bx = bx0, vcu = vcu0; asm volatile("" : "+s"(G), "+s"(bx), "+s"(vcu));     \
    const int tid = tid_fresh(), lane = tid & 63, wave = __builtin_amdgcn_readfirstlane(tid >> 6), gw = vcu * NWAVES + wave, NGW = G * NWAVES; (void)lane; (void)gw; (void)NGW; (void)bx; \
    unsigned char* ws = ka->ws; (void)ws; \
    float* MODP = (float*)(ws + WS_MODP); float* MOD = (float*)(ws + WS_MOD); (void)MODP; (void)MOD; \
    float* ROPE = (float*)(ws + WS_TAB + TAB_ROPE); bf16_t* M1 = (bf16_t*)(ws + WS_TAB + TAB_M1); bf16_t* W3 = (bf16_t*)(ws + WS_TAB + TAB_W3); (void)ROPE; (void)M1; (void)W3; \
    float* TW = (float*)(ws + WS_TAB + TAB_TW); float* TWC = (float*)(ws + WS_TAB + TAB_TWC); bf16_t* CSC = (bf16_t*)(ws + WS_TAB + TAB_CSC); (void)TW; (void)TWC; (void)CSC; \
    float* AFF = (float*)(ws + WS_AFF); int* SEL = (int*)(ws + WS_SEL); int* IDX = (int*)(ws + WS_IDX); (void)AFF; (void)SEL; (void)IDX; \
    unsigned char* WIN = ws + WS_WIN; bf16_t* WOUT = (bf16_t*)(ws + WS_WOUT); unsigned char* WGU = ws + WS_WGU; unsigned char* WD = ws + WS_WD; (void)WIN; (void)WOUT; (void)WGU; (void)WD; \
    bf16_t* X = (bf16_t*)(ws + WS_X); bf16_t* QKV = (bf16_t*)(ws + WS_QKV); bf16_t* OCAT = (bf16_t*)(ws + WS_OCAT); unsigned char* H = ws + WS_H; (void)X; (void)QKV; (void)OCAT; (void)H; \
    unsigned char* ACT = ws + WS_ACT; unsigned char* H2 = ws + WS_H2; bf16_t* YS = (bf16_t*)(ws + WS_YS); float* ST = (float*)(ws + WS_ST); (void)ACT; (void)H2; (void)YS; (void)ST;
#define PHASE_ENV_L \
    PHASE_ENV \
    const float* mod = MOD + (size_t)l * 9 * 6144; (void)mod; \
    const unsigned char* win = WIN + (size_t)l * NQ * DM * (INPROJ_F8 ? 1 : 2); const bf16_t* wout = WOUT + (size_t)l * DM * DM; (void)win; (void)wout; \
    const unsigned char* wgu = WGU + (size_t)l * NE * 4096 * DM; const unsigned char* wd = WD + (size_t)l * NE * DM * FF; (void)wgu; (void)wd;
constexpr int TAIL_IN = 2, TAIL_OUT = 4, TAIL_G2 = 3;
constexpr int TAIL_BLKS = 192 * TAIL_IN + 224 * TAIL_OUT + 192 * TAIL_G2;
__device__ __forceinline__ void cvt_expert_blocks(LAS unsigned char* lds, KArgs ka, unsigned char* WGU, unsigned char* WD, int wave, int lane, int base, int first, int step, int limit, int gap_at, int gap_len) {
    constexpr int XS = 132, XB = 256 * XS;
#define XBLK(j_) (first + (j_) * step)
#define XDEC(blk_, WT_, K_, kb_, nb_, wh_, sp_, N_) do { const int id_ = base + (blk_) + (((blk_) >= gap_at) ? gap_len : 0); const int le_ = id_ / 192, r_ = id_ % 192, q_ = r_ % 64; wh_ = r_ / 64; const float* src_; \
        if (wh_ < 2) { src_ = (wh_ == 0 ? ka->w_gate : ka->w_up) + (size_t)le_ * DM * FF; N_ = FF; kb_ = q_ / 8; nb_ = q_ % 8; WT_ = WGU + (size_t)le_ * 4096 * DM; K_ = DM; } \
        else { src_ = ka->w_down + (size_t)le_ * FF * DM; N_ = DM; kb_ = q_ / 4; nb_ = q_ % 4; WT_ = WD + (size_t)le_ * DM * FF; K_ = FF; } \
        sp_ = src_ + (size_t)(kb_ * 128 + wave * 16) * N_ + nb_ * 256 + 4 * lane; } while (0)
#define XLOAD(v_, sp_, N_) do { _Pragma("unroll") for (int i = 0; i < 16; ++i) v_[i] = *(const f32x4*)(sp_ + (size_t)i * N_); } while (0)
#define XOUT(bufi_, WT_, K_, kb_, nb_, wh_) do { const LAS unsigned char* bp_ = lds + (bufi_) * XB; \
        _Pragma("unroll") for (int jj = 0; jj < 4; ++jj) { const int row = 32 * wave + 8 * jj + (lane >> 3), c = lane & 7; const LAS unsigned* rp = (const LAS unsigned*)(bp_ + row * XS + 16 * c); \
            u32x4 o; o.x = rp[0]; o.y = rp[1]; o.z = rp[2]; o.w = rp[3]; \
            const int n = nb_ * 256 + row; const int orow = (wh_ < 2) ? 256 * (n >> 7) + (n & 127) + wh_ * 128 : n; \
            *(u32x4*)(WT_ + (size_t)orow * K_ + kb_ * 128 + 16 * c) = o; } } while (0)
#define XCVT(bufi_, v_) do { LAS unsigned char* bq_ = lds + (bufi_) * XB + (4 * lane) * XS + wave * 16; \
        _Pragma("unroll") for (int q4 = 0; q4 < 4; ++q4) _Pragma("unroll") for (int jn = 0; jn < 4; ++jn) \
            *(LAS unsigned*)(bq_ + jn * XS + 4 * q4) = pk4_fp8(v_[4 * q4][jn] * WSC8, v_[4 * q4 + 1][jn] * WSC8, v_[4 * q4 + 2][jn] * WSC8, v_[4 * q4 + 3][jn] * WSC8); } while (0)
    f32x4 va[16], vb[16];
    unsigned char* aWT = nullptr; int aK = 0, akb = 0, anb = 0, awh = 0; unsigned char* bWT = nullptr; int bK = 0, bkb = 0, bnb = 0, bwh = 0;
    unsigned char* pWT = nullptr; int pK = 0, pkb = 0, pnb = 0, pwh = 0; bool have_prev = false;
    { const int blk = XBLK(0); if (blk < limit) { const float* sp; int N; XDEC(blk, aWT, aK, akb, anb, awh, sp, N); XLOAD(va, sp, N); } }
    for (int j = 0;; j += 2) {
        { const int blk = XBLK(j); const bool valid = blk < limit; const int blk1 = XBLK(j + 1);
          if (valid && blk1 < limit) { const float* sp; int N; XDEC(blk1, bWT, bK, bkb, bnb, bwh, sp, N); XLOAD(vb, sp, N); }
          if (have_prev) XOUT(1, pWT, pK, pkb, pnb, pwh);
          if (!valid) break;
          XCVT(0, va); __syncthreads();
          have_prev = true; pWT = aWT; pK = aK; pkb = akb; pnb = anb; pwh = awh; }
        { const int blk = XBLK(j + 1); const bool valid = blk < limit; const int blk2 = XBLK(j + 2);
          if (valid && blk2 < limit) { const float* sp; int N; XDEC(blk2, aWT, aK, akb, anb, awh, sp, N); XLOAD(va, sp, N); }
          XOUT(0, pWT, pK, pkb, pnb, pwh);
          if (!valid) break;
          XCVT(1, vb); __syncthreads();
          pWT = bWT; pK = bK; pkb = bkb; pnb = bnb; pwh = bwh; } }
    __syncthreads();
#undef XBLK
#undef XDEC
#undef XLOAD
#undef XOUT
#undef XCVT
}
__global__ void __launch_bounds__(NWAVES * 64, 2) fwd_kernel(Args args) {
    extern __shared__ __attribute__((aligned(16))) unsigned char lds_raw[];
    LAS unsigned char* lds = (LAS unsigned char*)lds_raw;
    volatile LAS unsigned* MISC = (volatile LAS unsigned*)(lds + MISC_OFF);
    const int G0 = gridDim.x, bx0 = blockIdx.x;
    const int vcu0 = (G0 % 8 == 0) ? (bx0 % 8) * (G0 / 8) + bx0 / 8 : bx0;
    unsigned* ctl = (unsigned*)(args.ws + WS_CTL);
    for (int u = threadIdx.x; u < (LDS_BYTES - LDSCTL_OFF) / 4; u += NWAVES * 64) ((LAS unsigned*)(lds + LDSCTL_OFF))[u] = 0u;
    __syncthreads();
    XcdBarrier bar; bar.bar = ctl + CW_BAR; bar.x = 0; bar.st = nullptr;
    if (!MK_PER_PHASE) bar = xcd_barrier_post(ctl + CW_BAR, MISC + 8);
    const int lo = args.ph_lo, hi = args.ph_hi;
#define IN(k) (lo <= (k) && (k) < hi)
#define SEAM(k) do { if (IN(k) && IN((k) + 1)) { XcdBarrier b_ = bar; asm volatile("" : "+s"(b_.bar));     \
        xcd_barrier(b_); } } while (0)


    for (int rep_ = 0; rep_ < REPS(1); ++rep_)
    if (IN(0)) { PHASE_ENV
        __syncthreads();
        if (vcu >= G - 24) {
            LAS float* SL = (LAS float*)lds;
            for (int i = tid; i < 9 * DM; i += 512) { const int r = i >> 10, k = i & 1023; const float cv = (r < 8) ? ka->c[r * DM + k] : ka->c_ctx[k]; SL[i] = cv / (1.0f + expf(-cv)); }
            __syncthreads();
            const int it = (vcu - (G - 24)) * NWAVES + wave;
            const int l = it / 96, col = (it % 96) * 64 + lane; float acc[9];
#pragma unroll
            for (int r = 0; r < 9; ++r) acc[r] = 0.f;
            const float* wp = ka->w_ada + (size_t)l * DM * 6144 + col;
            for (int k = 0; k < DM; k += 16) { float w[16];
#pragma unroll
                for (int q = 0; q < 16; ++q) w[q] = wp[(size_t)(k + q) * 6144];
#pragma unroll
                for (int r = 0; r < 9; ++r)
#pragma unroll
                    for (int q4 = 0; q4 < 4; ++q4) { const f32x4 sv = *(const LAS f32x4*)(SL + r * DM + k + 4 * q4); acc[r] += sv.x * w[4 * q4] + sv.y * w[4 * q4 + 1] + sv.z * w[4 * q4 + 2] + sv.w * w[4 * q4 + 3]; } }
            const float bias = ka->b_ada[l * 6144 + col];
#pragma unroll
            for (int r = 0; r < 9; ++r) MOD[((size_t)l * 9 + r) * 6144 + col] = acc[r] + bias;
            __syncthreads();
        }
        { const int gt = vcu * 512 + tid;
          if (gt < 1024) { const int pos = gt >> 4, f = gt & 15; const float inv = powf(10000.0f, -(float)f / 16.0f); const float ang = (float)pos * inv; ROPE[2 * gt] = cosf(ang); ROPE[2 * gt + 1] = sinf(ang); }
          if (gt >= 1024 && gt < 1024 + 128 * 128) { const int i = gt - 1024, row = i >> 7, colk = i & 127; const int ro = row >> 6, k1 = row & 63, ri = colk >> 6, n1 = colk & 63;
              const float ang = 6.283185307179586f * (float)((k1 * n1) & 63) / 64.0f; const float cs = cosf(ang), sn = sinf(ang);
              const float v = (ro == 0) ? (ri == 0 ? cs : sn) : (ri == 0 ? -sn : cs); M1[i] = (bf16_t)f2bf(v); }
          if (gt >= 32768 && gt < 32768 + 64 * 128) { const int i = gt - 32768, k2 = i >> 7, colk = i & 127, ri = colk >> 6, n2 = colk & 63;
              const float ang = 6.283185307179586f * (float)((k2 * n2) & 63) / 64.0f; const float v = (ri == 0 ? cosf(ang) : sinf(ang)) * (1.0f / 512.0f); W3[i] = (bf16_t)f2bf(v); }
          if (gt >= 65536 && gt < 65536 + 4096) { const int i = gt - 65536, k1 = i >> 6, n2 = i & 63; const float ang = 6.283185307179586f * (float)(k1 * n2) / 4096.0f; TW[2 * i] = cosf(ang); TW[2 * i + 1] = sinf(ang); }
          for (int i = gt; i < 256 * 512; i += G * 512) { const int k = i >> 9, kk = i & 511, ri = kk >> 8, n = kk & 255; const float ang = 6.283185307179586f * (float)((k * n) & 255) / 256.0f;
              CSC[i] = (bf16_t)f2bf((ri == 0 ? cosf(ang) : sinf(ang)) * (1.0f / 128.0f)); }
          if (gt >= 80000 && gt < 80000 + 256) { const int j = gt - 80000; const float ang = 6.283185307179586f * (float)j / 256.0f; TWC[2 * j] = cosf(ang); TWC[2 * j + 1] = sinf(ang); } }
        for (int it = gw; it < 2 * 4 * DM; it += NGW) { const int k = it & 1023, g = (it >> 10) & 3, l = it >> 12;
            const float wv = ka->w_in[((size_t)l * DM + k) * 1792 + 768 + g * 64 + lane];
            float ar = 0.f, ai = 0.f;
            for (int c = 0; c < 64; ++c) { const float wc_ = __builtin_bit_cast(float, __builtin_amdgcn_readlane(__builtin_bit_cast(int, wv), c)); const float ang = 6.283185307179586f * (float)((lane * c) & 63) / 64.0f; ar += wc_ * __cosf(ang); ai -= wc_ * __sinf(ang); }
#if INPROJ_F8
            unsigned char* wt = WIN + (size_t)l * NQ * DM; const unsigned pq = pk4_fp8(ar * WSC8, ai * WSC8, 0.f, 0.f);
            wt[(size_t)(C_VR + g * 64 + lane) * DM + k] = (unsigned char)(pq & 0xffu); wt[(size_t)(C_VI + g * 64 + lane) * DM + k] = (unsigned char)((pq >> 8) & 0xffu); }
#else
            bf16_t* wt = (bf16_t*)WIN + (size_t)l * NQ * DM;
            wt[(size_t)(C_VR + g * 64 + lane) * DM + k] = (bf16_t)f2bf(ar); wt[(size_t)(C_VI + g * 64 + lane) * DM + k] = (bf16_t)f2bf(ai); }
#endif
        { LAS float* scr = (LAS float*)(lds + wave * 16896);
          constexpr int I_IN = 16 * 24, I_OUT = 16 * 16, I_L = I_IN + I_OUT;
          for (int it = gw; it < 2 * I_L; it += NGW) {
            const int l = it / I_L; int r = it % I_L;
            if (r < I_IN) { const int kb = r / 24; int nb = r % 24; if (nb >= 12) nb += 4;
                const int n0 = 64 * nb; const float sc = (n0 >= 1024 && n0 < 1280) ? C2 : 1.0f;
                int orow, orow1;
                if (n0 < 512) { const int hq = n0 >> 6; orow = (hq >> 2) * 256 + 32 * (hq & 3); orow1 = orow + 128; }
                else if (n0 < 768) { const int slot = (n0 - 512) >> 6; orow = 512 + 32 * slot; orow1 = orow + 128; }
                else { orow = n0 + 256; orow1 = orow + 32; }
#if INPROJ_F8
                tr_item8(ka->w_in + (size_t)l * DM * 1792, 1792, 64 * kb, n0, WIN + (size_t)l * NQ * DM, DM, orow, orow1, sc * WSC8, scr, lane); continue; }
#else
                tr_item(ka->w_in + (size_t)l * DM * 1792, 1792, 64 * kb, n0, (bf16_t*)WIN + (size_t)l * NQ * DM, DM, orow, orow1, sc, nullptr, scr, lane); continue; }
#endif
            r -= I_IN;
            { const int kb = r / 16, nb = r % 16; const int k0 = 64 * kb;
                const float* ks = (k0 < 512) ? ka->g_out_a + l * 512 : (k0 < 768) ? ka->g_out_b + l * 256 - 512 : ka->g_out_c + l * 256 - 768;
                tr_item(ka->w_out + (size_t)l * DM * DM, DM, k0, 64 * nb, WOUT + (size_t)l * DM * DM, DM, 64 * nb, 64 * nb + 32, 1.0f, ks, scr, lane); } } }
        __syncthreads();
        { const bool is_ada = vcu >= G - 24; const int n_oth = G - 24; constexpr int NV = 6144 - TAIL_BLKS; const int lim_oth = NV - 24 * 6;
          if (is_ada) cvt_expert_blocks(lds, ka, WGU, WD, wave, lane, 0, lim_oth + (vcu - n_oth), 24, NV, 3072, TAIL_BLKS);
          else cvt_expert_blocks(lds, ka, WGU, WD, wave, lane, 0, vcu, n_oth, lim_oth, 3072, TAIL_BLKS); }
    }
    SEAM(0);
    const int nlayers = (DBG_STOP >= 3) ? 2 : 1;
    for (int l = 0; l < nlayers; ++l) {
        const int P = 1 + l * PH_PER_LAYER;
        for (int rep_ = 0; rep_ < REPS(7); ++rep_)
        if (IN(P + 0) && l == 0) { PHASE_ENV_L
            for (int m = gw; m < MROWS; m += NGW) { const int b = m / TT, t = m % TT; const bool isctx = t >= SEQ;
                const float* src = isctx ? ka->ctx + ((size_t)b * CTX + (t - SEQ)) * DM : ka->x + ((size_t)b * SEQ + t) * DM;
                f32x4 v[4];
#pragma unroll
                for (int j = 0; j < 4; ++j) v[j] = *(const f32x4*)(src + 4 * lane + 256 * j);
                store_row_bf16(X + (size_t)m * DM, v, lane);
                const float* mr = mod + (size_t)(isctx ? 8 : b) * 6144;
                norm_mod_row(v, ka->g_mix + l * DM, mr, mr + 1024, lane);
                if (INPROJ_F8) store_row_fp8(H + (size_t)m * DM, v, lane); else store_row_bf16((bf16_t*)H + (size_t)m * DM, v, lane); }
        }
        SEAM(P + 0);
        for (int rep_ = 0; rep_ < REPS(2); ++rep_)
        if (IN(P + 1)) { PHASE_ENV_L
            pg8::Gemm g{(const bf16_t*)H, (const bf16_t*)win, INPROJ_F8 ? DM / 2 : DM}; pg8::GridOrder S; S.init(MROWS / 256, NQ / 256, G, bx, 0);
            pg8::EpiInProj E{QKV, ka->g_q + l * 64, ka->g_k + l * 64, ROPE, INPROJ_F8 ? 1.0f / WSC8 : 1.0f};
            pg8::gemm_phase<pg8::EpiInProj, pg8::GridOrder, true, false, false, (INPROJ_F8 != 0)>(lds, g, S, E);
            if (l == 0 && bx >= 64) { __syncthreads(); cvt_expert_blocks(lds, ka, WGU, WD, wave, lane, 3072, bx - 64, 192, 192 * TAIL_IN, 1 << 30, 0); }
        }
        SEAM(P + 1);
        for (int rep_ = 0; rep_ < REPS(3); ++rep_)
        if (IN(P + 2)) { PHASE_ENV_L
            const attn::bf16* QKVb = (const attn::bf16*)QKV; attn::bf16* OC = (attn::bf16*)OCAT;
#if ATT_F8
#define QKP(off_, idx_) ((const attn::bf16*)((const unsigned char*)(QKVb + (off_)) + (idx_)))
#else
#define QKP(off_, idx_) (QKVb + (off_) + (idx_))
#endif
#if PV_F8
#define VP_(off_, idx_) QKP(off_, idx_)
#else
#define VP_(off_, idx_) (QKVb + (off_) + (idx_))
#endif
            if (DBG_GROUPS & 1) {
            for (int i = 0; i < 4 * REPS(10); ++i) { const int u = (i & 3) * 256 + vcu, grp = u >> 6, b = grp >> 1, kvh = grp & 1, w = u & 63, h = kvh * 4 + (w >> 4), qb = w & 15;
                const size_t qrow = (size_t)b * TT + 256 * qb;
                attn::attn_unit<8, false, 512, 128>(QKP(O_QA, qrow * 512 + h * 64), QKP(O_KA, kvh * 64), VP_(O_VA, kvh * 64), OC + qrow * DM + h * 64, (char*)lds_raw,
                                          68, 68, b * TT, 0, 68, 0, 0, 0, ST + qrow * 80 + h); }
            }
            if (DBG_GROUPS & 4) {
            for (int i = 0; i < 2 * REPS(9); ++i) { const int u = (i & 1) * 256 + vcu, b = u >> 6, w = u & 63, h = w >> 4, qb = w & 15;
                { LAS float* rbt = (LAS float*)(lds + attn::LDS_RB);
                  for (int i2 = tid; i2 < 15 * 128; i2 += 512) { const int dr = i2 >> 7, ii = (i2 & 127) - 48; rbt[i2] = (ii >= 0 && ii < 31) ? ka->rel_bias[(((size_t)l * 4 + h) * 15 + dr) * 31 + ii] * LOG2E : 0.f; }
                  __syncthreads(); }
                const int r0 = 4 * qb; int kr_lo = r0 - 4; kr_lo = kr_lo < 0 ? 0 : (kr_lo > 56 ? 56 : kr_lo); int kr_hi = r0 + 3 - 4; kr_hi = kr_hi < 0 ? 0 : (kr_hi > 56 ? 56 : kr_hi); kr_hi += 7;
                const int n_win = kr_hi - kr_lo + 1; const int nvalid = 4 + n_win; const int NT = (nvalid + 1) & ~1;
                const size_t qrow = (size_t)b * TT + 256 * qb;
                attn::attn_unit<8, true, 256, 256>(QKP(O_QN, qrow * 256 + h * 64), QKP(O_KN, h * 64), VP_(O_VN, h * 64), OC + qrow * DM + 768 + h * 64, (char*)lds_raw,
                                         NT, 4, b * TT + SEQ, b * TT + 64 * kr_lo, nvalid, r0, kr_lo, n_win, ST + qrow * 80 + 8 + h); }
            }
            if (DBG_GROUPS & 2) {
            fourier_tables_to_lds(lds, M1, W3);
            for (int i = 0; i < REPS(8); ++i) { const int u = vcu; fourier_unit2(lds, QKV, OCAT, TW, ST, u >> 5, (u >> 3) & 3, u & 7); }
            }
            if (l == 0) {
                if (vcu < 64) { const int b = vcu >> 3, h = vcu & 7, kvh = h >> 2; const size_t qrow = (size_t)b * TT + SEQ;
                    attn::attn_unit<8, false, 512, 128>(QKP(O_QA, qrow * 512 + h * 64), QKP(O_KA, kvh * 64), VP_(O_VA, kvh * 64), OC + qrow * DM + h * 64, (char*)lds_raw,
                                              4, 4, b * TT + SEQ, 0, 4, 0, 0, 0, ST + qrow * 80 + h); }
                else if (vcu < 96) { const int b = (vcu - 64) >> 2, h = (vcu - 64) & 3; const size_t qrow = (size_t)b * TT + SEQ;
                    attn::attn_unit<8, false, 256, 256>(QKP(O_QN, qrow * 256 + h * 64), QKP(O_KN, h * 64), VP_(O_VN, h * 64), OC + qrow * DM + 768 + h * 64, (char*)lds_raw,
                                              4, 4, b * TT + SEQ, 0, 4, 0, 0, 0, ST + qrow * 80 + 8 + h); }
                else if (vcu < 128) { const int u = vcu - 96; fourier_ctx_unit(lds, QKV, OCAT, CSC, ST, u >> 2, u & 3); }
            }
        }
        SEAM(P + 2);
        for (int rep_ = 0; rep_ < ((l == 0) ? REPS(7) : 1); ++rep_)
        if (IN(P + 3)) { PHASE_ENV_L
            pg8::Gemm g{OCAT, wout, DM}; pg8::GridOrder S; S.init(l == 0 ? MROWS / 256 : 128, DM / 256, G, bx, l == 1);
            for (int ui = 0; ui < 3; ++ui) { pg8::Unit u; if (!S.next(ui, u)) break;
                LAS float* rs = (LAS float*)(lds + RS_OFF) + ui * 768;
                if (tid < 256) { const f32x4* p = (const f32x4*)(ST + ((size_t)u.pm * 256 + tid) * 80);
                    f32x4 q[19];
#pragma unroll
                    for (int i = 0; i < 19; ++i) q[i] = p[i];
                    const f32x4 a4 = q[0] + q[1]; f32x4 b4 = q[3];
#pragma unroll
                    for (int i = 4; i < 19; ++i) b4 = b4 + q[i];
                    const float sa = (a4.x + a4.y) + (a4.z + a4.w), sc = (q[2].x + q[2].y) + (q[2].z + q[2].w), sb = (b4.x + b4.y) + (b4.z + b4.w);
                    const float ra = 1.0f / sqrtf(sa * (1.f / 512.f) + EPS), rb = 1.0f / sqrtf(sb * (1.f / 256.f) + EPS), rc = 1.0f / sqrtf(sc * (1.f / 256.f) + EPS);
                    rs[tid * 3 + 0] = ra / rb; rs[tid * 3 + 1] = rb / rc; rs[tid * 3 + 2] = rc; } }
            __syncthreads();
            pg8::EpiResid E{X, mod + 2 * 1024, (DBG_STOP >= 1) ? 1.0f : 0.0f, nullptr};
            pg8::gemm_phase<pg8::EpiResid, pg8::GridOrder, true, false, true>(lds, g, S, E);
            if (l == 0 && bx >= 32) { __syncthreads(); cvt_expert_blocks(lds, ka, WGU, WD, wave, lane, 3072, 192 * TAIL_IN + (bx - 32), 224, 192 * TAIL_IN + 224 * TAIL_OUT, 1 << 30, 0); }
        }
        SEAM(P + 3);
        for (int rep_ = 0; rep_ < REPS(6) + REPS(11) - 1; ++rep_)
        if (IN(P + 4)) { PHASE_ENV_L
            LAS bf16_t* WRH = (LAS bf16_t*)lds;
            LAS bf16_t* WRL = WRH + 16384;
            LAS float* GAB = (LAS float*)(lds + 65536);
            LAS float* SHB = GAB + 1024;
            LAS float* GAC = SHB + 1024; LAS float* SHC = GAC + 1024;
            const int bwg = vcu >> 5;
            for (int pp = 0; pp < (l == 0 ? 2 : 1); ++pp) {
                const int r = lane & 15, g = lane >> 4;
                const bool valid = (pp == 0) || (r == 0);
                const int bb = (pp == 0) ? bwg : (gw >> 8); const int t0 = (pp == 0) ? (gw & 255) * 16 : SEQ + (gw & 255);
                const size_t mrow = (size_t)bb * TT + t0 + ((pp == 0) ? r : 0);
                const LAS float* GA = (pp == 0) ? GAB : GAC; const LAS float* SH = (pp == 0) ? SHB : SHC;
                const bf16_t* xrow = X + mrow * DM + 8 * g;
                float ss = 0.f;
                u32x4 xr[16];
#pragma unroll
                for (int c = 0; c < 16; ++c) xr[c] = valid ? *(const u32x4*)(xrow + 32 * (c + 16)) : (u32x4){0u, 0u, 0u, 0u};
                if (pp == 0) {
                { f32x4 w4[8];
    #pragma unroll
                  for (int i = 0; i < 8; ++i) { const int idx = tid + 512 * i; w4[i] = *(const f32x4*)(ka->w_router + ((size_t)l * DM + (idx >> 2)) * 16 + (idx & 3) * 4); }
    #pragma unroll
                  for (int i = 0; i < 8; ++i) { const int idx = tid + 512 * i, k = idx >> 2, e4 = (idx & 3) * 4;
    #pragma unroll
                    for (int j = 0; j < 4; ++j) { const float w = w4[i][j]; const unsigned hi = f2bf(w), lo = f2bf(w - bf2f((unsigned short)hi)); const int off = ((((k >> 5) * 4 + ((k >> 3) & 3)) * 16 + e4 + j) << 3) + (k & 7);
                        WRH[off] = (bf16_t)hi; WRL[off] = (bf16_t)lo; } } }
                for (int k = tid; k < DM; k += 512) { const float gf = ka->g_ffn[l * DM + k]; const float* mr = mod + (size_t)bwg * 6144; GAB[k] = gf * (1.0f + mr[4 * 1024 + k]); SHB[k] = mr[3 * 1024 + k];
                    if (l == 0) { const float* mc = mod + (size_t)8 * 6144; GAC[k] = gf * (1.0f + mc[4 * 1024 + k]); SHC[k] = mc[3 * 1024 + k]; } }
                __syncthreads();
                }
#pragma unroll 8
                for (int c = 0; c < 16; ++c) { const u32x4 w = valid ? *(const u32x4*)(xrow + 32 * c) : (u32x4){0u, 0u, 0u, 0u};
                    ss += (bflo(w.x) * bflo(w.x) + bfhi(w.x) * bfhi(w.x)) + (bflo(w.y) * bflo(w.y) + bfhi(w.y) * bfhi(w.y)) + (bflo(w.z) * bflo(w.z) + bfhi(w.z) * bfhi(w.z)) + (bflo(w.w) * bflo(w.w) + bfhi(w.w) * bfhi(w.w)); }
#pragma unroll
                for (int c = 0; c < 16; ++c) { const u32x4 w = xr[c];
                    ss += (bflo(w.x) * bflo(w.x) + bfhi(w.x) * bfhi(w.x)) + (bflo(w.y) * bflo(w.y) + bfhi(w.y) * bfhi(w.y)) + (bflo(w.z) * bflo(w.z) + bfhi(w.z) * bfhi(w.z)) + (bflo(w.w) * bflo(w.w) + bfhi(w.w) * bfhi(w.w)); }
                ss += shx(ss, 16, lane); ss += shx(ss, 32, lane);
                const float rstd = 1.0f / sqrtf(ss * (1.f / DM) + EPS);
                f32x4 acc = (f32x4){0.f, 0.f, 0.f, 0.f};
#pragma unroll
                for (int c = 0; c < 32; ++c) { const u32x4 w = (c >= 16) ? xr[c & 15] : (valid ? *(const u32x4*)(xrow + 32 * c) : (u32x4){0u, 0u, 0u, 0u}); const int k0 = 32 * c + 8 * g;
                    const f32x4 ga0 = *(const LAS f32x4*)(GA + k0), ga1 = *(const LAS f32x4*)(GA + k0 + 4), sh0 = *(const LAS f32x4*)(SH + k0), sh1 = *(const LAS f32x4*)(SH + k0 + 4);
                    float h[8] = {bflo(w.x), bfhi(w.x), bflo(w.y), bfhi(w.y), bflo(w.z), bfhi(w.z), bflo(w.w), bfhi(w.w)};
                    h[0] = h[0] * rstd * ga0.x + sh0.x; h[1] = h[1] * rstd * ga0.y + sh0.y; h[2] = h[2] * rstd * ga0.z + sh0.z; h[3] = h[3] * rstd * ga0.w + sh0.w;
                    h[4] = h[4] * rstd * ga1.x + sh1.x; h[5] = h[5] * rstd * ga1.y + sh1.y; h[6] = h[6] * rstd * ga1.z + sh1.z; h[7] = h[7] * rstd * ga1.w + sh1.w;
                    u32x4 hi4; hi4.x = pk2(h[0], h[1]); hi4.y = pk2(h[2], h[3]); hi4.z = pk2(h[4], h[5]); hi4.w = pk2(h[6], h[7]);
                    u32x4 lo4; lo4.x = pk2(h[0] - bflo(hi4.x), h[1] - bfhi(hi4.x)); lo4.y = pk2(h[2] - bflo(hi4.y), h[3] - bfhi(hi4.y)); lo4.z = pk2(h[4] - bflo(hi4.z), h[5] - bfhi(hi4.z)); lo4.w = pk2(h[6] - bflo(hi4.w), h[7] - bfhi(hi4.w));
                    if (valid) { u32x2 h8; h8.x = pk4_fp8(h[0], h[1], h[2], h[3]); h8.y = pk4_fp8(h[4], h[5], h[6], h[7]); *(u32x2*)(H2 + mrow * DM + k0) = h8; }
                    const bf16x8 bh = *(const LAS bf16x8*)(WRH + (((c * 4 + g) * 16 + r) << 3)), bl = *(const LAS bf16x8*)(WRL + (((c * 4 + g) * 16 + r) << 3));
                    const bf16x8 ah = __builtin_bit_cast(bf16x8, hi4), al = __builtin_bit_cast(bf16x8, lo4);
                    acc = __builtin_amdgcn_mfma_f32_16x16x32_bf16(ah, bh, acc, 0, 0, 0);
                    acc = __builtin_amdgcn_mfma_f32_16x16x32_bf16(ah, bl, acc, 0, 0, 0);
                    acc = __builtin_amdgcn_mfma_f32_16x16x32_bf16(al, bh, acc, 0, 0, 0); }
                f32x4 av;
#pragma unroll
                for (int q = 0; q < 4; ++q) { const float x = acc[q]; float mx = x; mx = fmaxf(mx, shx(mx, 1, lane)); mx = fmaxf(mx, shx(mx, 2, lane)); mx = fmaxf(mx, shx(mx, 4, lane)); mx = fmaxf(mx, shx(mx, 8, lane));
                    const float ex = expf(x - mx); float den = ex; den += shx(den, 1, lane); den += shx(den, 2, lane); den += shx(den, 4, lane); den += shx(den, 8, lane); av[q] = ex / den; }
                float* ap = AFF + ((size_t)bb * NE + r) * TT + t0;
                if (pp == 0) *(f32x4*)(ap + 4 * g) = av;
                else if (g == 0) ap[0] = av[0];
            }
            __syncthreads();
        }
        SEAM(P + 4);
        for (int rep_ = 0; rep_ < REPS(6) + REPS(12) - 1; ++rep_)
        if (IN(P + 5)) { PHASE_ENV_L
            LAS unsigned* hist = (LAS unsigned*)lds;
            LAS unsigned* sh = hist + 256;
            const int nunits = (l == 0) ? 256 : 128;
            for (int u = vcu; u < nunits; u += G) { const int set = u >> 7, b = (u >> 4) & 7, e = u & 15;
                const int n = set ? CTX : SEQ, kk = set ? CAPC : CAP, t0 = set ? SEQ : 0;
                const float* ap = AFF + ((size_t)b * NE + e) * TT + t0;
                unsigned key[8]; const int nper = set ? 1 : 8; const bool act = set ? (tid < 256) : true;
#pragma unroll
                for (int i = 0; i < 8; ++i) key[i] = (act && i < nper) ? __float_as_uint(ap[tid * nper + i]) : 0u;
                unsigned prefix = 0u; unsigned krem = (unsigned)kk;
                for (int pass = 0; pass < 4; ++pass) { const int shift = 24 - 8 * pass;
                    if (tid < 256) hist[tid] = 0u;
                    __syncthreads();
#pragma unroll
                    for (int i = 0; i < 8; ++i) if (act && i < nper) { const unsigned kv = key[i]; const bool match = (pass == 0) || ((kv >> (shift + 8)) == prefix); if (match) __hip_atomic_fetch_add(&hist[(kv >> shift) & 255u], 1u, __ATOMIC_RELAXED, __HIP_MEMORY_SCOPE_WORKGROUP); }
                    __syncthreads();
                    if (wave == 0) {
                        const unsigned h0 = hist[4 * lane], h1 = hist[4 * lane + 1], h2 = hist[4 * lane + 2], h3 = hist[4 * lane + 3];
                        const unsigned tot = h0 + h1 + h2 + h3; unsigned suf = tot;
#pragma unroll
                        for (int o = 1; o < 64; o <<= 1) { const unsigned v = shidx(suf, (lane + o) & 63); if (lane + o < 64) suf += v; }
                        const unsigned above = suf - tot;
                        unsigned cum = above; int found = -1; unsigned cabove = 0;
                        if (found < 0 && cum + h3 >= krem && cum < krem) { found = 4 * lane + 3; cabove = cum; } cum += h3;
                        if (found < 0 && cum + h2 >= krem && cum < krem) { found = 4 * lane + 2; cabove = cum; } cum += h2;
                        if (found < 0 && cum + h1 >= krem && cum < krem) { found = 4 * lane + 1; cabove = cum; } cum += h1;
                        if (found < 0 && cum + h0 >= krem && cum < krem) { found = 4 * lane + 0; cabove = cum; }
                        if (found >= 0) { sh[0] = (prefix << 8) | (unsigned)found; sh[1] = krem - cabove; }
                    }
                    __syncthreads();
                    prefix = sh[0]; krem = sh[1];
                    __syncthreads();
                }
                unsigned cg = 0, ce = 0;
#pragma unroll
                for (int i = 0; i < 8; ++i) if (act && i < nper) { cg += key[i] > prefix; ce += key[i] == prefix; }
                unsigned packed = cg | (ce << 16);
                unsigned incl = packed;
#pragma unroll
                for (int o = 1; o < 64; o <<= 1) { const unsigned v = shidx(incl, (lane - o) & 63); if (lane >= o) incl += v; }
                if (lane == 63) sh[8 + wave] = incl;
                __syncthreads();
                unsigned wbase = 0, total = 0;
#pragma unroll
                for (int w2 = 0; w2 < 8; ++w2) { const unsigned s = sh[8 + w2]; if (w2 < wave) wbase += s; total += s; }
                const unsigned excl = wbase + incl - packed; unsigned og = excl & 0xffffu, oe = excl >> 16; const unsigned ngt = total & 0xffffu;
                const int slot0 = set ? (SEQ + b * CAPC) : (b * CAP);
#pragma unroll
                for (int i = 0; i < 8; ++i) if (act && i < nper) { const int tok = tid * nper + i; const int m = b * TT + t0 + tok; int slotrow = -1;
                    if (key[i] > prefix) { slotrow = slot0 + (int)og; ++og; }
                    else if (key[i] == prefix) { if (oe < krem) slotrow = slot0 + (int)(ngt + oe); ++oe; }
                    SEL[(size_t)m * NE + e] = slotrow;
                    if (slotrow >= 0) IDX[e * EROWS + slotrow] = m; }
                __syncthreads();
            }
        }
        SEAM(P + 5);
        for (int rep_ = 0; rep_ < REPS(4); ++rep_)
        if (IN(P + 6)) { PHASE_ENV_L
            pg8::Gemm g{(const bf16_t*)H2, (const bf16_t*)wgu, DM / 2}; pg8::MoeOrder S; S.init(l == 0 ? 17 : 16, 16, bx);
            pg8::EpiSwiGLU8 E{ACT, 1.0f / WSC8};
            pg8::gemm_phase<pg8::EpiSwiGLU8, pg8::MoeOrder, true, true, false, true>(lds, g, S, E, IDX);
        }
        SEAM(P + 6);
        for (int rep_ = 0; rep_ < REPS(5); ++rep_)
        if (IN(P + 7)) { PHASE_ENV_L
            pg8::Gemm g{(const bf16_t*)ACT, (const bf16_t*)wd, FF / 2}; pg8::MoeOrder S; S.init(l == 0 ? 17 : 16, 4, bx);
            pg8::EpiStoreS E{YS, DM, 1.0f / WSC8};
            pg8::gemm_phase<pg8::EpiStoreS, pg8::MoeOrder, true, false, false, true>(lds, g, S, E);
            if (l == 0 && bx >= 64) { __syncthreads(); cvt_expert_blocks(lds, ka, WGU, WD, wave, lane, 3072, 192 * TAIL_IN + 224 * TAIL_OUT + (bx - 64), 192, TAIL_BLKS, 1 << 30, 0); }
        }
        SEAM(P + 7);
        for (int rep_ = 0; rep_ < REPS(13); ++rep_)
        if (IN(P + 8)) { PHASE_ENV_L
            int ckey = -1; f32x4 g5[4], ga[4], sh[4];
#pragma unroll
            for (int j = 0; j < 4; ++j) { g5[j] = (f32x4){0.f, 0.f, 0.f, 0.f}; ga[j] = g5[j]; sh[j] = g5[j]; }
            f32x4 nv[4]; int nsel = -1; float naff = 0.f;
            const bool to_next = (l == 0 && DBG_STOP >= 3);
#define CMB_LOAD(mm) do { const int b_ = (mm) / TT, t_ = (mm) % TT; \
                _Pragma("unroll") for (int j = 0; j < 4; ++j) { const u32x2 xw_ = *(const u32x2*)(X + (size_t)(mm) * DM + 4 * lane + 256 * j); nv[j] = (f32x4){bflo(xw_.x), bfhi(xw_.x), bflo(xw_.y), bfhi(xw_.y)}; } \
                nsel = (lane < 16) ? SEL[(size_t)(mm) * NE + lane] : -1; naff = (lane < 16) ? AFF[((size_t)b_ * NE + lane) * TT + t_] : 0.f; } while (0)
            const int mbase = gw * 17;
            CMB_LOAD(mbase);
            for (int ri = 0; ri < 17; ++ri) { const int m = mbase + ri; const int b = m / TT, t = m % TT; const bool isctx = t >= SEQ;
                f32x4 v[4];
#pragma unroll
                for (int j = 0; j < 4; ++j) v[j] = nv[j];
                const int selv = nsel; const float affv = naff;
                if (ri < 16) CMB_LOAD(m + 1);
                if (l == 1 && isctx) continue;
                const int key = isctx ? 8 : b;
                if (key != ckey) { ckey = key; const float* mr5 = mod + (size_t)key * 6144 + 5 * 1024;
#pragma unroll
                    for (int j = 0; j < 4; ++j) { const int c = 4 * lane + 256 * j; g5[j] = *(const f32x4*)(mr5 + c);
                        if (to_next) { const float* mr = MOD + (size_t)9 * 6144 + (size_t)key * 6144; const f32x4 gv = *(const f32x4*)(ka->g_mix + DM + c), sc = *(const f32x4*)(mr + 1024 + c); ga[j] = gv * (sc + 1.0f); sh[j] = *(const f32x4*)(mr + c); }
                        else { ga[j] = *(const f32x4*)(ka->g_final + c); sh[j] = (f32x4){0.f, 0.f, 0.f, 0.f}; } } }
                if (DBG_STOP >= 2 + 2 * l) {
                f32x4 ma[4];
#pragma unroll
                for (int j = 0; j < 4; ++j) ma[j] = (f32x4){0.f, 0.f, 0.f, 0.f};
                unsigned mask = (unsigned)__ballot(selv >= 0) & 0xffffu;
                while (mask) {
                    int sr[4]; float gt[4];
#if YS_F8
                    const unsigned char* yr[4];
#else
                    const bf16_t* yr[4];
#endif
#pragma unroll
                    for (int u = 0; u < 4; ++u) { const bool has = mask != 0u; const int e = has ? (__builtin_ffs((int)mask) - 1) : 0; if (has) mask &= mask - 1u;
                        sr[u] = __builtin_amdgcn_readlane(selv, e); gt[u] = __builtin_bit_cast(float, __builtin_amdgcn_readlane(__builtin_bit_cast(int, affv), e));
                        if (!has) { sr[u] = 0; gt[u] = 0.f; }
#if YS_F8
                        yr[u] = (const unsigned char*)YS + ((size_t)e * EROWS + sr[u]) * DM; }
                    unsigned w[4][4];
#pragma unroll
                    for (int u = 0; u < 4; ++u)
#pragma unroll
                        for (int j = 0; j < 4; ++j) w[u][j] = *(const unsigned*)(yr[u] + 4 * lane + 256 * j);
#pragma unroll
                    for (int u = 0; u < 4; ++u)
#pragma unroll
                        for (int j = 0; j < 4; ++j) { const f32x2 lo_ = __builtin_amdgcn_cvt_pk_f32_fp8((int)w[u][j], false), hi_ = __builtin_amdgcn_cvt_pk_f32_fp8((int)w[u][j], true);
                            ma[j].x += gt[u] * lo_[0]; ma[j].y += gt[u] * lo_[1]; ma[j].z += gt[u] * hi_[0]; ma[j].w += gt[u] * hi_[1]; }
#else
                        yr[u] = YS + ((size_t)e * EROWS + sr[u]) * DM; }
                    u32x2 w[4][4];
#pragma unroll
                    for (int u = 0; u < 4; ++u)
#pragma unroll
                        for (int j = 0; j < 4; ++j) w[u][j] = *(const u32x2*)(yr[u] + 4 * lane + 256 * j);
#pragma unroll
                    for (int u = 0; u < 4; ++u)
#pragma unroll
                        for (int j = 0; j < 4; ++j) { ma[j].x += gt[u] * bflo(w[u][j].x); ma[j].y += gt[u] * bfhi(w[u][j].x); ma[j].z += gt[u] * bflo(w[u][j].y); ma[j].w += gt[u] * bfhi(w[u][j].y); }
#endif
                }
#pragma unroll
                for (int j = 0; j < 4; ++j) v[j] = v[j] + g5[j] * ma[j];
                }
                if (to_next) {
#pragma unroll
                    for (int j = 0; j < 4; ++j) { u32x2 xw; xw.x = pk2(v[j].x, v[j].y); xw.y = pk2(v[j].z, v[j].w); *(u32x2*)(((REPS(13) > 1 && rep_ == 0) ? QKV : X) + (size_t)m * DM + 4 * lane + 256 * j) = xw; }
                }
                if (to_next || !isctx) {
                    float ss = 0.f;
#pragma unroll
                    for (int j = 0; j < 4; ++j) ss += (v[j].x * v[j].x + v[j].y * v[j].y) + (v[j].z * v[j].z + v[j].w * v[j].w);
                    const float r = 1.0f / sqrtf(wave_sum(ss, lane) * (1.f / DM) + EPS);
#pragma unroll
                    for (int j = 0; j < 4; ++j) v[j] = v[j] * r * ga[j] + sh[j];
                    if (to_next) { if (INPROJ_F8) store_row_fp8(H + (size_t)m * DM, v, lane); else store_row_bf16((bf16_t*)H + (size_t)m * DM, v, lane); }
                    else {
#pragma unroll
                        for (int j = 0; j < 4; ++j) *(f32x4*)(ka->out + ((size_t)b * SEQ + t) * DM + 4 * lane + 256 * j) = v[j]; }
                }
            }
#undef CMB_LOAD
        }
        if (l == 0) SEAM(P + 8);
    }
#undef IN
#undef SEAM
}

extern "C" void kernel_launch(void* const* d_in, const int* in_sizes, int n_in, void* d_out, int out_size, void* d_ws, size_t ws_size, hipStream_t stream) {
    static int grid = 0;
    if (grid == 0) {
        if (n_in != 21 || out_size != NB * SEQ * DM || ws_size < WS_END) { fprintf(stderr, "kernel_launch: unexpected problem (n_in %d, out %d, ws %zu)\n", n_in, out_size, ws_size); grid = -1; return; }
        int dev = 0, cus = 0, per_cu = 0;
        if (hipGetDevice(&dev) != hipSuccess || hipDeviceGetAttribute(&cus, hipDeviceAttributeMultiprocessorCount, dev) != hipSuccess) { grid = -1; return; }
        if (hipFuncSetAttribute((const void*)fwd_kernel, hipFuncAttributeMaxDynamicSharedMemorySize, LDS_BYTES) != hipSuccess) { fprintf(stderr, "kernel_launch: hipFuncSetAttribute failed\n"); grid = -1; return; }
        if (hipOccupancyMaxActiveBlocksPerMultiprocessor(&per_cu, (const void*)fwd_kernel, NWAVES * 64, LDS_BYTES) != hipSuccess || per_cu < 1) fprintf(stderr, "kernel_launch: occupancy query reports %d\n", per_cu);
        (void)hipGetLastError();
        grid = cus;
        if (grid != 256) { fprintf(stderr, "kernel_launch: built for 256 CUs, got %d\n", grid); grid = -1; return; }
    }
    if (grid < 0) return;
    if (hipMemsetAsync((char*)d_ws + WS_CTL, 0, CTL_ZERO_BYTES, stream) != hipSuccess) return;
    Args a{};
    const float** ap = (const float**)&a;
    for (int i = 0; i < 21; ++i) ap[i] = (const float*)d_in[i];
    a.out = (float*)d_out; a.ws = (unsigned char*)d_ws;
#if MK_PER_PHASE
    for (int p = 0; p < NPHASE; ++p) { a.ph_lo = p; a.ph_hi = p + 1; hipLaunchKernelGGL(fwd_kernel, dim3(grid), dim3(NWAVES * 64), LDS_BYTES, stream, a); }
#else
    a.ph_lo = 0; a.ph_hi = NPHASE;
    hipLaunchKernelGGL(fwd_kernel, dim3(grid), dim3(NWAVES * 64), LDS_BYTES, stream, a);
#endif
}
```
